# Optimizing an MI355X kernel written in HIP

```python
import jax, jax.numpy as jnp
from jax import lax
import numpy as np

D_MODEL = 1024
BATCH = 16
SEQ = 2048
DEPTH = 1
DEC_BATCH = 32
DEC_SEQ = 32
PAST_LEN = 2048

CHUNK = 64
D_LRU = D_MODEL
N_LRU_HEADS = 16
LRU_BLOCK = D_LRU // N_LRU_HEADS
LRU_C = 8.0
CONV_W = 4
POOL_WINDOWS = (2, 4, 8, 16)
N_POOL_GROUPS = len(POOL_WINDOWS)
D_POOL = D_MODEL // 2
POOL_GROUP = D_POOL // N_POOL_GROUPS
POOL_OUT_GROUP = D_MODEL // N_POOL_GROUPS
POOL_STATE = max(POOL_WINDOWS) - 1
D_PLE = 256
EPS = 1e-6
SPLITS = (D_LRU, 2 * D_LRU, 2 * D_LRU + D_POOL, 2 * D_LRU + D_POOL + D_MODEL,
          2 * D_LRU + D_POOL + 2 * D_MODEL)
IN_COLS = 2 * D_LRU + D_POOL + 3 * D_MODEL

kernel_name = "hybrid_rglru_pool_streaming_step"


def rmsnorm(x, g):
    xf = x.astype(jnp.float32)
    y = xf * lax.rsqrt(jnp.mean(xf * xf, axis=-1, keepdims=True) + EPS)
    return (y * g.astype(jnp.float32)).astype(x.dtype)


def causal_conv(x, state, w, b):
    T = x.shape[1]
    z = jnp.concatenate([state.astype(x.dtype), x], axis=1)
    y = sum(z[:, k:k + T] * w[k] for k in range(CONV_W)) + b
    return y, z[:, -(CONV_W - 1):]


def rg_lru(x, h0, pos0, w_a, b_a, w_i, b_i, lam):
    B, T, _ = x.shape
    xb = x.reshape(B, T, N_LRU_HEADS, LRU_BLOCK)
    r = jax.nn.sigmoid(jnp.einsum('bthi,hij->bthj', xb, w_a).reshape(B, T, D_LRU) + b_a)
    i = jax.nn.sigmoid(jnp.einsum('bthi,hij->bthj', xb, w_i).reshape(B, T, D_LRU) + b_i)
    log_a = -LRU_C * r.astype(jnp.float32) * jax.nn.softplus(-lam.astype(jnp.float32))
    a = jnp.exp(log_a)
    mult = jnp.sqrt(-jnp.expm1(2.0 * log_a))
    pos = (pos0 + jnp.arange(T))[None, :, None]
    mult = jnp.where(pos == 0, 1.0, mult)
    bterm = mult * (i.astype(jnp.float32) * x.astype(jnp.float32))
    bterm = bterm.at[:, 0].add(a[:, 0] * h0.astype(jnp.float32))

    def combine(left, right):
        a1, b1 = left
        a2, b2 = right
        return a1 * a2, a2 * b1 + b2

    _, h = lax.associative_scan(combine, (a, bterm), axis=1)
    return h.astype(x.dtype), h[:, -1].astype(h0.dtype)


def multi_pool(x, state, pos0):
    B, T, _ = x.shape
    z_raw = jnp.concatenate([state.astype(x.dtype), x], axis=1)
    z = z_raw.astype(jnp.float32)
    c = jnp.concatenate([jnp.zeros((B, 1, D_POOL), jnp.float32), jnp.cumsum(z, axis=1)], axis=1)
    pos = pos0 + jnp.arange(T)
    outs = []
    for g, w in enumerate(POOL_WINDOWS):
        sl = slice(g * POOL_GROUP, (g + 1) * POOL_GROUP)
        end = c[:, POOL_STATE + 1:POOL_STATE + 1 + T, sl]
        start = c[:, POOL_STATE + 1 - w:POOL_STATE + 1 - w + T, sl]
        cnt = jnp.minimum(w, pos + 1).astype(jnp.float32)[None, :, None]
        outs.append((end - start) / cnt - z[:, POOL_STATE:, sl])
    pooled = jnp.concatenate(outs, axis=-1).astype(x.dtype)
    return pooled, z_raw[:, -POOL_STATE:].astype(state.dtype)


def mixer_layer(x, p, conv_s, lru_s, pool_s, pos0, norm_mix, w_in, conv_w, conv_b,
                w_rg_a, b_rg_a, w_rg_i, b_rg_i, lru_lambda, w_pool, b_pool, pool_scale,
                w_out, norm_ple, w_ple_gate, w_ple):
    B, T, _ = x.shape
    u = rmsnorm(x, norm_mix)
    proj = u @ w_in
    xl, gl, xp, gp, ml, mp = jnp.split(proj, SPLITS, axis=-1)
    xc, new_conv = causal_conv(xl, conv_s, conv_w, conv_b)
    h, new_lru = rg_lru(xc, lru_s, pos0, w_rg_a, b_rg_a, w_rg_i, b_rg_i, lru_lambda)
    lru_out = h * jax.nn.silu(gl)
    pooled, new_pool = multi_pool(xp, pool_s, pos0)
    pg = jnp.einsum('btgi,gij->btgj', pooled.reshape(B, T, N_POOL_GROUPS, POOL_GROUP), w_pool) + b_pool
    pool_out = pg.reshape(B, T, D_MODEL) * pool_scale * jax.nn.silu(gp)
    merged = jax.nn.sigmoid(ml) * lru_out + jax.nn.sigmoid(mp) * pool_out
    x = x + merged @ w_out
    gate = jax.nn.sigmoid(rmsnorm(x, norm_ple) @ w_ple_gate)
    x = x + gate * (p @ w_ple)
    return x, new_conv, new_lru, new_pool


def setup_inputs(seed: int = 0) -> dict:
    key = jax.random.key(seed)
    ks = jax.random.split(key, 32)
    f32 = jnp.float32
    nrm = lambda k, shape, s: jax.random.normal(k, shape, f32) * s
    a0 = jax.random.uniform(ks[13], (DEPTH, D_LRU), f32, 0.9, 0.999)
    s = a0 ** (1.0 / LRU_C)
    lru_lambda = jnp.log(s) - jnp.log1p(-s)
    return {
        "x_prompt": nrm(ks[0], (BATCH, SEQ, D_MODEL), 1.0),
        "x_sample": nrm(ks[1], (DEC_BATCH, DEC_SEQ, D_MODEL), 1.0),
        "p_prompt": nrm(ks[2], (DEPTH, BATCH, SEQ, D_PLE), 1.0),
        "p_sample": nrm(ks[3], (DEPTH, DEC_BATCH, DEC_SEQ, D_PLE), 1.0),
        "state_conv": nrm(ks[4], (DEPTH, DEC_BATCH, CONV_W - 1, D_LRU), 1.0),
        "state_lru": nrm(ks[5], (DEPTH, DEC_BATCH, D_LRU), 0.5),
        "state_pool": nrm(ks[6], (DEPTH, DEC_BATCH, POOL_STATE, D_POOL), 1.0),
        "norm_mix": 1.0 + nrm(ks[7], (DEPTH, D_MODEL), 0.05),
        "w_in": nrm(ks[8], (DEPTH, D_MODEL, IN_COLS), D_MODEL ** -0.5),
        "conv_w": nrm(ks[9], (DEPTH, CONV_W, D_LRU), CONV_W ** -0.5),
        "conv_b": nrm(ks[10], (DEPTH, D_LRU), 0.02),
        "w_rg_a": nrm(ks[11], (DEPTH, N_LRU_HEADS, LRU_BLOCK, LRU_BLOCK), LRU_BLOCK ** -0.5),
        "b_rg_a": nrm(ks[12], (DEPTH, D_LRU), 0.02),
        "w_rg_i": nrm(ks[14], (DEPTH, N_LRU_HEADS, LRU_BLOCK, LRU_BLOCK), LRU_BLOCK ** -0.5),
        "b_rg_i": nrm(ks[15], (DEPTH, D_LRU), 0.02),
        "lru_lambda": lru_lambda,
        "w_pool": nrm(ks[16], (DEPTH, N_POOL_GROUPS, POOL_GROUP, POOL_OUT_GROUP), POOL_GROUP ** -0.5),
        "b_pool": nrm(ks[17], (DEPTH, N_POOL_GROUPS, POOL_OUT_GROUP), 0.02),
        "pool_scale": 1.0 + nrm(ks[18], (DEPTH, D_MODEL), 0.1),
        "w_out": nrm(ks[19], (DEPTH, D_MODEL, D_MODEL), D_MODEL ** -0.5),
        "norm_ple": 1.0 + nrm(ks[20], (DEPTH, D_MODEL), 0.05),
        "w_ple_gate": nrm(ks[21], (DEPTH, D_MODEL, D_MODEL), D_MODEL ** -0.5),
        "w_ple": nrm(ks[22], (DEPTH, D_PLE, D_MODEL), D_PLE ** -0.5),
        "final_norm": 1.0 + nrm(ks[23], (D_MODEL,), 0.05),
    }


def reference(x_prompt, x_sample, p_prompt, p_sample, state_conv, state_lru, state_pool,
              norm_mix, w_in, conv_w, conv_b, w_rg_a, b_rg_a, w_rg_i, b_rg_i, lru_lambda,
              w_pool, b_pool, pool_scale, w_out, norm_ple, w_ple_gate, w_ple, final_norm):
    dt = x_prompt.dtype
    bp = x_prompt.shape[0]
    hp, hs = x_prompt, x_sample
    conv_p_l, lru_p_l, pool_p_l = [], [], []
    conv_s_l, lru_s_l, pool_s_l = [], [], []
    for i in range(DEPTH):
        wts = (norm_mix[i], w_in[i], conv_w[i], conv_b[i], w_rg_a[i], b_rg_a[i], w_rg_i[i],
               b_rg_i[i], lru_lambda[i], w_pool[i], b_pool[i], pool_scale[i], w_out[i],
               norm_ple[i], w_ple_gate[i], w_ple[i])
        hp, cp, lp, pp = mixer_layer(
            hp, p_prompt[i],
            jnp.zeros((bp, CONV_W - 1, D_LRU), dt),
            jnp.zeros((bp, D_LRU), state_lru.dtype),
            jnp.zeros((bp, POOL_STATE, D_POOL), dt),
            0, *wts)
        hs, cs, ls, ps = mixer_layer(
            hs, p_sample[i], state_conv[i], state_lru[i], state_pool[i],
            PAST_LEN, *wts)
        conv_p_l.append(cp); lru_p_l.append(lp); pool_p_l.append(pp)
        conv_s_l.append(cs); lru_s_l.append(ls); pool_s_l.append(ps)
    y_prompt = rmsnorm(hp, final_norm)
    y_sample = rmsnorm(hs, final_norm)
    return (y_prompt, y_sample,
            jnp.stack(conv_p_l, 0), jnp.stack(lru_p_l, 0), jnp.stack(pool_p_l, 0),
            jnp.stack(conv_s_l, 0), jnp.stack(lru_s_l, 0), jnp.stack(pool_s_l, 0))
```

```cpp
#include <hip/hip_runtime.h>
#include <hip/hip_cooperative_groups.h>
#include <cstdio>
#include <cstdint>
namespace cg = cooperative_groups;

#define LAS __attribute__((address_space(3)))
typedef unsigned short bf16_t;
typedef short bf16x8 __attribute__((ext_vector_type(8)));
typedef float f32x4 __attribute__((ext_vector_type(4)));
typedef float f32x2 __attribute__((ext_vector_type(2)));
typedef unsigned u32x4 __attribute__((ext_vector_type(4)));
typedef unsigned u32x2 __attribute__((ext_vector_type(2)));

constexpr int D = 1024, SEQ = 2048, NB = 16, DB = 32, DS = 32;
constexpr int NP = NB * SEQ;
constexpr int NS = DB * DS;
constexpr int M = NP + NS;
constexpr int INC = 5632, DPLE = 256, DPOOL = 512;
constexpr int C_XL = 0, C_GL = 1024, C_XP = 2048, C_GP = 2560, C_ML = 3584, C_MP = 4608;
constexpr float EPS = 1e-6f;
constexpr int PAST = 2048;

constexpr size_t MiB = 1u << 20;
constexpr size_t WS_CTL = 0, CTL_ZERO_BYTES = 1 * MiB;
constexpr size_t WS_WIN = 1 * MiB;
constexpr size_t WS_WOUT = 12 * MiB;
constexpr size_t WS_WPG = 14 * MiB;
constexpr size_t WS_WPE = 16 * MiB;
constexpr size_t WS_WRA = 16 * MiB + 512 * 1024;
constexpr size_t WS_WRI = WS_WRA + 128 * 1024;
constexpr size_t WS_WPOOL = WS_WRI + 128 * 1024;
constexpr size_t WS_PB = 17 * MiB;
constexpr size_t WS_U = 34 * MiB;
constexpr size_t WS_MERGED = WS_U;
constexpr size_t WS_SS2 = 100 * MiB;
constexpr size_t WS_SS3 = 103 * MiB;
constexpr size_t WS_PROJ = 106 * MiB;
constexpr size_t WS_X2B = WS_PROJ;
constexpr size_t WS_PE = WS_PROJ + 66 * MiB;
constexpr size_t WS_END = 469 * MiB;
static_assert(WS_PROJ + (size_t)M * INC * 2 <= WS_END, "ws map");

constexpr size_t O_Y = 0;
constexpr size_t O_CONV_P = (size_t)M * D;
constexpr size_t O_LRU_P = O_CONV_P + (size_t)NB * 3 * D;
constexpr size_t O_POOL_P = O_LRU_P + (size_t)NB * D;
constexpr size_t O_CONV_S = O_POOL_P + (size_t)NB * 15 * DPOOL;
constexpr size_t O_LRU_S = O_CONV_S + (size_t)DB * 3 * D;
constexpr size_t O_POOL_S = O_LRU_S + (size_t)DB * D;
constexpr size_t O_END = O_POOL_S + (size_t)DB * 15 * DPOOL;

constexpr int NWAVES = 8;
constexpr int LDS_BYTES = 147456;

namespace pg8 {
constexpr int BM = 256, BK = 64, HALF = 128, HTB = HALF * BK * 2, STAGE_BYTES = 8 * HTB, NXCD = 8, WGM = 8;
__host__ __device__ __forceinline__ int lds_byte(int r, int c) { const int st = (r >> 4) * 2 + (c >> 5), rr = r & 15, cc = c & 31, ob = rr * 64 + cc * 2; return st * 1024 + (ob ^ (((ob >> 9) & 1) << 5)); }
__host__ __device__ __forceinline__ void stage_rc(int b, int& R, int& C) { const int st = b / 1024, sb = b % 1024, swz = sb ^ (((sb >> 9) & 1) << 5); R = (st >> 1) * 16 + swz / 64; C = (st & 1) * 32 + (swz % 64) / 2; }
__host__ __device__ __forceinline__ int perm32(int rho) { const int n = rho >> 4, i = rho & 15; return 8 * (i >> 2) + 4 * n + (i & 3); }

struct Unit { int pm, pn; };
struct Gemm { const bf16_t* A; const bf16_t* Bt; int M, N, K; };

struct StaticOrder {
    int nM, nN, nwg, G, c;
    __host__ __device__ void init(int M_, int N_, int G_, int c_) { nM = M_ / BM; nN = N_ / BM; nwg = nM * nN; G = G_; c = c_; }
    __host__ __device__ bool next(int i, Unit& u) const {
        const long L = (long)i * G + c; if (L >= nwg) return false;
        int wgid = (int)L; { const int q = nwg / NXCD, r = nwg % NXCD, xcd = wgid % NXCD, off = wgid / NXCD; wgid = (xcd < r ? xcd * (q + 1) : r * (q + 1) + (xcd - r) * q) + off; }
        const int nig = WGM * nN, gid = wgid / nig, fm = gid * WGM, gsz = (nM - fm) < WGM ? (nM - fm) : WGM;
        u.pm = fm + ((wgid % nig) % gsz); u.pn = (wgid % nig) / gsz; return true;
    }
    __device__ __forceinline__ void a_ready(const Unit&) const {}
    __device__ __forceinline__ void done(const Unit&) const {}
};

__device__ __forceinline__ unsigned cvt_pk_bf16(float lo, float hi) { unsigned r; asm volatile("v_cvt_pk_bf16_f32 %0, %1, %2" : "=v"(r) : "v"(lo), "v"(hi)); return r; }

struct EpiBf16 {
    static constexpr bool PERM = true, AFTER_DRAIN = false;
    bf16_t* O; int ldc;
    __device__ __forceinline__ void operator()(const f32x4 (&acc)[2][2][4][2], const Unit& u, int wr, int wc, int fr, int fq) const {
        const int row0 = u.pm * BM + wr * 64 + fr; const int col0 = u.pn * BM + wc * 32 + 8 * fq;
#pragma unroll
        for (int ai = 0; ai < 2; ++ai)
#pragma unroll
            for (int m = 0; m < 4; ++m) { bf16_t* rowp = O + (size_t)(row0 + ai * HALF + m * 16) * ldc + col0;
#pragma unroll
                for (int bj = 0; bj < 2; ++bj) { const f32x4 v0 = acc[ai][bj][m][0], v1 = acc[ai][bj][m][1];
                    u32x4 w; w.x = cvt_pk_bf16(v0[0], v0[1]); w.y = cvt_pk_bf16(v0[2], v0[3]); w.z = cvt_pk_bf16(v1[0], v1[1]); w.w = cvt_pk_bf16(v1[2], v1[3]);
                    *(u32x4*)(rowp + bj * HALF) = w; } }
    }
};
struct EpiRes1 {
    static constexpr bool PERM = false, AFTER_DRAIN = false;
    const float* xp; const float* xs; float* out; bf16_t* x2b; float* ss;
    __device__ __forceinline__ void operator()(const f32x4 (&acc)[2][2][4][2], const Unit& u, int wr, int wc, int fr, int fq) const {
        const int row0 = u.pm * BM + wr * 64 + fr, col0 = u.pn * BM + wc * 32 + 4 * fq;
        const float* xbase = (u.pm < NP / BM) ? xp : xs - (size_t)NP * D;
#pragma unroll
        for (int ai = 0; ai < 2; ++ai)
#pragma unroll
            for (int m = 0; m < 4; ++m) { const int row = row0 + ai * HALF + m * 16; const size_t off = (size_t)row * D + col0; float s = 0.f;
#pragma unroll
                for (int bj = 0; bj < 2; ++bj)
#pragma unroll
                    for (int n = 0; n < 2; ++n) { const f32x4 xv = *(const f32x4*)(xbase + off + bj * HALF + n * 16); const f32x4 v = xv + acc[ai][bj][m][n];
                        *(f32x4*)(out + off + bj * HALF + n * 16) = v; s += (v[0] * v[0] + v[1] * v[1]) + (v[2] * v[2] + v[3] * v[3]);
                        u32x2 w; w.x = cvt_pk_bf16(v[0], v[1]); w.y = cvt_pk_bf16(v[2], v[3]); *(u32x2*)(x2b + off + bj * HALF + n * 16) = w; }
                s += __shfl_xor(s, 16); s += __shfl_xor(s, 32);
                if (fq == 0) ss[(size_t)row * 16 + u.pn * 4 + wc] = s;
                asm volatile("" ::: "memory"); }
    }
};
struct EpiGate {
    static constexpr bool PERM = false, AFTER_DRAIN = false;
    float* out; const bf16_t* pe; const float* ss2; float* ss3;
    __device__ __forceinline__ void operator()(const f32x4 (&acc)[2][2][4][2], const Unit& u, int wr, int wc, int fr, int fq) const {
        const int row0 = u.pm * BM + wr * 64 + fr, col0 = u.pn * BM + wc * 32 + 4 * fq;
#pragma unroll
        for (int ai = 0; ai < 2; ++ai)
#pragma unroll
            for (int m = 0; m < 4; ++m) { const int row = row0 + ai * HALF + m * 16; const size_t off = (size_t)row * D + col0;
                const f32x4 pv = *(const f32x4*)(ss2 + (size_t)row * 16 + 4 * fq); float t = (pv[0] + pv[1]) + (pv[2] + pv[3]);
                t += __shfl_xor(t, 16); t += __shfl_xor(t, 32);
                const float rstd = 1.0f / sqrtf(t * (1.0f / D) + EPS); float s = 0.f;
#pragma unroll
                for (int bj = 0; bj < 2; ++bj)
#pragma unroll
                    for (int n = 0; n < 2; ++n) { const size_t o = off + bj * HALF + n * 16; const f32x4 x2 = *(const f32x4*)(out + o); const u32x2 pw = *(const u32x2*)(pe + o);
                        const f32x4 a = acc[ai][bj][m][n] * rstd; f32x4 v;
                        const float p0 = __uint_as_float(pw.x << 16), p1 = __uint_as_float(pw.x & 0xffff0000u), p2 = __uint_as_float(pw.y << 16), p3 = __uint_as_float(pw.y & 0xffff0000u);
                        v[0] = x2[0] + p0 / (1.0f + __expf(-a[0])); v[1] = x2[1] + p1 / (1.0f + __expf(-a[1]));
                        v[2] = x2[2] + p2 / (1.0f + __expf(-a[2])); v[3] = x2[3] + p3 / (1.0f + __expf(-a[3]));
                        *(f32x4*)(out + o) = v; s += (v[0] * v[0] + v[1] * v[1]) + (v[2] * v[2] + v[3] * v[3]); }
                s += __shfl_xor(s, 16); s += __shfl_xor(s, 32);
                if (fq == 0) ss3[(size_t)row * 16 + u.pn * 4 + wc] = s;
                asm volatile("" ::: "memory"); }
    }
};

template <class Epi, class Sched, bool ALIGN_EPI = false, bool SP2 = false>
__device__ __forceinline__ void gemm_phase(LAS unsigned char* lds, const Gemm g, const Sched& S, const Epi& E) {
    const int tid = threadIdx.x, wid = __builtin_amdgcn_readfirstlane(tid >> 6), lane = tid & 63, wr = wid >> 2, wc = wid & 3, fr = lane & 15, fq = lane >> 4;
    const int K = g.K, nt = K / BK;
    unsigned voffA[2], voffB[2];
#pragma unroll
    for (int i = 0; i < 2; ++i) { int R, C; stage_rc(tid * 16 + i * 8192, R, C); const int Rb = Epi::PERM ? ((R & ~31) + perm32(R & 31)) : R;
        voffA[i] = (unsigned)(R * K + C) * 2u; voffB[i] = (unsigned)(Rb * K + C) * 2u; }
    const size_t kstep = (size_t)(BK * 2);
    const size_t hstep = (size_t)HALF * K * 2;
    const size_t tstep = 2 * hstep;
    const unsigned ldsw = (unsigned)wid * 1024u;
    const int aoff = lds_byte(wr * 64 + fr, fq * 8), boff = lds_byte(wc * 32 + fr, fq * 8);
#define PG8_SA(b, h) (((b) * 2 + (h)) * HTB)
#define PG8_SB(b, h) ((4 + (b) * 2 + (h)) * HTB)
#define PG8_STAGE(bufoff, gbase, voff) do { _Pragma("unroll") for (int _i = 0; _i < 2; ++_i) \
        __builtin_amdgcn_global_load_lds((const unsigned*)((const char*)(gbase) + (voff)[_i]), (LAS unsigned*)(lds + (bufoff) + ldsw + _i * 8192), 16, 0, 0); } while (0)
#define PG8_LDA(dst, b, h) do { _Pragma("unroll") for (int m = 0; m < 4; ++m) _Pragma("unroll") for (int k = 0; k < 2; ++k) dst[m][k] = *(const LAS bf16x8*)(lds + PG8_SA(b, h) + aoff + m * 2048 + k * 1024); } while (0)
#define PG8_LDB(dst, b, h) do { _Pragma("unroll") for (int n = 0; n < 2; ++n) _Pragma("unroll") for (int k = 0; k < 2; ++k) dst[n][k] = *(const LAS bf16x8*)(lds + PG8_SB(b, h) + boff + n * 2048 + k * 1024); } while (0)
#define PG8_MMA(ai, bj, At, Bt) do { __builtin_amdgcn_s_setprio(1); _Pragma("unroll") for (int m = 0; m < 4; ++m) _Pragma("unroll") for (int n = 0; n < 2; ++n) _Pragma("unroll") for (int k = 0; k < 2; ++k) \
        acc[ai][bj][m][n] = __builtin_amdgcn_mfma_f32_16x16x32_bf16(Bt[n][k], At[m][k], acc[ai][bj][m][n], 0, 0, 0); __builtin_amdgcn_s_setprio(0); } while (0)
#define PG8_WAIT_V(n) asm volatile("s_waitcnt vmcnt(" #n ")" ::: "memory")
#define PG8_WAIT_L(n) asm volatile("s_waitcnt lgkmcnt(" #n ")" ::: "memory")
#define PG8_BAR __builtin_amdgcn_s_barrier()
#define PG8_SCHED __builtin_amdgcn_sched_barrier(0)
    Unit cur, nxt; int ui = 0;
    if (!S.next(0, cur)) return;
    f32x4 acc[2][2][4][2];
#pragma unroll
    for (int a = 0; a < 2; ++a)
#pragma unroll
        for (int b = 0; b < 2; ++b)
#pragma unroll
            for (int m = 0; m < 4; ++m)
#pragma unroll
                for (int n = 0; n < 2; ++n) acc[a][b][m][n] = (f32x4){0.f, 0.f, 0.f, 0.f};
    bf16x8 At[4][2], B0[2][2], B1[2][2];
    const char* cA = (const char*)g.A + (size_t)cur.pm * tstep; const char* cB = (const char*)g.Bt + (size_t)cur.pn * tstep;
    S.a_ready(cur);
    if constexpr (SP2) {
        PG8_STAGE(PG8_SB(0, 0), cB, voffB); PG8_STAGE(PG8_SB(0, 1), cB + hstep, voffB); PG8_STAGE(PG8_SA(0, 0), cA, voffA); PG8_STAGE(PG8_SA(0, 1), cA + hstep, voffA);
        if (wr == 1) PG8_BAR;
        PG8_WAIT_V(2); PG8_BAR;
        PG8_STAGE(PG8_SB(1, 0), cB + kstep, voffB); PG8_STAGE(PG8_SA(1, 0), cA + kstep, voffA); PG8_STAGE(PG8_SB(1, 1), cB + hstep + kstep, voffB);
        PG8_WAIT_V(6); PG8_BAR;
    } else {
        PG8_STAGE(PG8_SB(0, 0), cB, voffB); PG8_STAGE(PG8_SA(0, 0), cA, voffA); PG8_STAGE(PG8_SB(0, 1), cB + hstep, voffB); PG8_STAGE(PG8_SA(0, 1), cA + hstep, voffA);
        if (wr == 1) PG8_BAR;
        PG8_WAIT_V(4); PG8_BAR;
        PG8_STAGE(PG8_SB(1, 0), cB + kstep, voffB); PG8_STAGE(PG8_SA(1, 0), cA + kstep, voffA); PG8_STAGE(PG8_SB(1, 1), cB + hstep + kstep, voffB);
        PG8_WAIT_V(6); PG8_BAR;
    }
    for (;;) {
        const bool has_next = S.next(ui + 1, nxt);
        const char* nA = has_next ? (const char*)g.A + (size_t)nxt.pm * tstep : cA; const char* nB = has_next ? (const char*)g.Bt + (size_t)nxt.pn * tstep : cB;
        for (int t = 0; t < nt; t += 2) {
            const bool last = (t == nt - 2);
            const char* a1 = cA + (size_t)(t + 1) * kstep;
            const char* a2 = last ? nA : cA + (size_t)(t + 2) * kstep; const char* b2 = last ? nB : cB + (size_t)(t + 2) * kstep;
            const char* a3 = a2 + kstep; const char* b3 = b2 + kstep;
            if (last && has_next) S.a_ready(nxt);
            if constexpr (SP2) {
            PG8_LDB(B0, 0, 0); PG8_LDB(B1, 0, 1); PG8_SCHED; PG8_LDA(At, 0, 0); PG8_STAGE(PG8_SA(1, 1), a1 + hstep, voffA);
            PG8_WAIT_V(8); PG8_WAIT_L(0); PG8_BAR; PG8_MMA(0, 0, At, B0); PG8_MMA(0, 1, At, B1); PG8_BAR; PG8_SCHED;
            PG8_LDA(At, 0, 1); PG8_STAGE(PG8_SB(0, 0), b2, voffB); PG8_STAGE(PG8_SB(0, 1), b2 + hstep, voffB); PG8_STAGE(PG8_SA(0, 0), a2, voffA);
            PG8_WAIT_V(8); PG8_WAIT_L(0); PG8_BAR; PG8_MMA(1, 0, At, B0); PG8_MMA(1, 1, At, B1); PG8_BAR; PG8_SCHED;
            PG8_LDB(B0, 1, 0); PG8_LDB(B1, 1, 1); PG8_SCHED; PG8_LDA(At, 1, 0); PG8_STAGE(PG8_SA(0, 1), a2 + hstep, voffA);
            PG8_WAIT_V(8); PG8_WAIT_L(0); PG8_BAR; PG8_MMA(0, 0, At, B0); PG8_MMA(0, 1, At, B1); PG8_BAR; PG8_SCHED;
            PG8_LDA(At, 1, 1); PG8_STAGE(PG8_SB(1, 0), b3, voffB); PG8_STAGE(PG8_SB(1, 1), b3 + hstep, voffB); PG8_STAGE(PG8_SA(1, 0), a3, voffA);
            PG8_WAIT_V(8); PG8_WAIT_L(0); PG8_BAR; PG8_MMA(1, 0, At, B0); PG8_MMA(1, 1, At, B1); PG8_BAR; PG8_SCHED;
            } else {
            PG8_LDB(B0, 0, 0); PG8_SCHED; PG8_LDA(At, 0, 0); PG8_STAGE(PG8_SA(1, 1), a1 + hstep, voffA);
            PG8_WAIT_L(8); PG8_BAR; PG8_WAIT_L(0); PG8_MMA(0, 0, At, B0); PG8_BAR; PG8_SCHED;
            PG8_LDB(B1, 0, 1); PG8_STAGE(PG8_SB(0, 0), b2, voffB);
            PG8_BAR; PG8_WAIT_L(0); PG8_MMA(0, 1, At, B1); PG8_BAR;
            PG8_LDA(At, 0, 1); PG8_STAGE(PG8_SA(0, 0), a2, voffA);
            PG8_BAR; PG8_WAIT_L(0); PG8_MMA(1, 0, At, B0); PG8_BAR; PG8_SCHED;
            PG8_STAGE(PG8_SB(0, 1), b2 + hstep, voffB);
            PG8_WAIT_V(6); PG8_BAR; PG8_MMA(1, 1, At, B1); PG8_BAR;
            PG8_LDB(B0, 1, 0); PG8_SCHED; PG8_LDA(At, 1, 0); PG8_STAGE(PG8_SA(0, 1), a2 + hstep, voffA);
            PG8_WAIT_L(8); PG8_BAR; PG8_WAIT_L(0); PG8_MMA(0, 0, At, B0); PG8_BAR; PG8_SCHED;
            PG8_LDB(B1, 1, 1); PG8_STAGE(PG8_SB(1, 0), b3, voffB);
            PG8_BAR; PG8_WAIT_L(0); PG8_MMA(0, 1, At, B1); PG8_BAR;
            PG8_LDA(At, 1, 1); PG8_STAGE(PG8_SA(1, 0), a3, voffA);
            PG8_BAR; PG8_WAIT_L(0); PG8_MMA(1, 0, At, B0); PG8_BAR; PG8_SCHED;
            PG8_STAGE(PG8_SB(1, 1), b3 + hstep, voffB);
            PG8_WAIT_V(6); PG8_BAR; PG8_MMA(1, 1, At, B1); PG8_BAR;
            }
        }
        if constexpr (ALIGN_EPI) { if (wr == 0) PG8_BAR; }
        E(acc, cur, wr, wc, fr, fq); S.done(cur);
        if (!has_next) break;
#pragma unroll
        for (int a = 0; a < 2; ++a)
#pragma unroll
            for (int b = 0; b < 2; ++b)
#pragma unroll
                for (int m = 0; m < 4; ++m)
#pragma unroll
                    for (int n = 0; n < 2; ++n) acc[a][b][m][n] = (f32x4){0.f, 0.f, 0.f, 0.f};
        cur = nxt; cA = nA; cB = nB; ++ui;
        if constexpr (ALIGN_EPI) { if (wr == 1) PG8_BAR; }
    }
    PG8_WAIT_V(0);
    if constexpr (!ALIGN_EPI) { if (wr == 0) PG8_BAR; }
    PG8_BAR;
#undef PG8_SA
#undef PG8_SB
#undef PG8_STAGE
#undef PG8_LDA
#undef PG8_LDB
#undef PG8_MMA
#undef PG8_WAIT_V
#undef PG8_WAIT_L
#undef PG8_BAR
#undef PG8_SCHED
}
}

#define LDS_WAIT() asm volatile("s_waitcnt lgkmcnt(0)" ::: "memory")
__device__ __forceinline__ unsigned f2bf(float f) { unsigned u = __float_as_uint(f); return (u + 0x7fffu + ((u >> 16) & 1u)) >> 16; }
__device__ __forceinline__ unsigned pk2(float lo, float hi) { return f2bf(lo) | (f2bf(hi) << 16); }
__device__ __forceinline__ float bf2f(bf16_t v) { return __uint_as_float(((unsigned)v) << 16); }
__device__ __forceinline__ float wave_sum(float v) {
#pragma unroll
    for (int o = 1; o < 64; o <<= 1) v += __shfl_xor(v, o);
    return v;
}
__device__ __forceinline__ float sigm(float x) { return 1.0f / (1.0f + __expf(-x)); }
__device__ __forceinline__ float one_minus_exp(float x) {
    const float p = -x * (1.0f + x * (0.5f + x * (1.0f / 6.0f + x * (1.0f / 24.0f + x * (1.0f / 120.0f + x * (1.0f / 720.0f))))));
    const float q = 1.0f - __expf(x);
    return x > -0.25f ? p : q;
}

struct Args { const float* in[24]; float* out; unsigned char* ws; int ph_lo, ph_hi; };

__device__ __forceinline__ void p0_transpose_item(const float* W, int K, int N, bf16_t* WT, const float* kscale, LAS float* scr, int item, int lane) {
    const int nblk = N / 32, kb = item / nblk, nb = item % nblk, k0 = 64 * kb, n0 = 32 * nb;
#pragma unroll 8
    for (int i = 0; i < 32; ++i) { const int kk = 2 * i + (lane >> 5); const float sc = kscale ? kscale[k0 + kk] : 1.0f; scr[kk * 33 + (lane & 31)] = W[(size_t)(k0 + kk) * N + n0 + (lane & 31)] * sc; }
    LDS_WAIT(); asm volatile("" ::: "memory");
    const int c = lane & 7;
#pragma unroll
    for (int j = 0; j < 4; ++j) { const int n = (lane >> 3) + 8 * j; const LAS float* s = scr + (8 * c) * 33 + n;
        u32x4 o; o.x = pk2(s[0 * 33], s[1 * 33]); o.y = pk2(s[2 * 33], s[3 * 33]); o.z = pk2(s[4 * 33], s[5 * 33]); o.w = pk2(s[6 * 33], s[7 * 33]);
        *(u32x4*)(WT + (size_t)(n0 + n) * K + k0 + 8 * c) = o; }
    LDS_WAIT(); asm volatile("" ::: "memory");
}

__global__ void __launch_bounds__(NWAVES * 64, 2) fwd(Args args) {
    extern __shared__ __attribute__((aligned(16))) unsigned char lds_raw[];
    LAS unsigned char* lds = (LAS unsigned char*)lds_raw;
    const int tid = threadIdx.x, lane = tid & 63, wave = __builtin_amdgcn_readfirstlane(tid >> 6);
    const int G = gridDim.x, bid = blockIdx.x;
    const int gw = bid * NWAVES + wave, NGW = G * NWAVES;
    unsigned char* ws = args.ws;
    const float* x_prompt = args.in[0]; const float* x_sample = args.in[1]; const float* p_prompt = args.in[2]; const float* p_sample = args.in[3];
    const float* state_conv = args.in[4]; const float* state_lru = args.in[5]; const float* state_pool = args.in[6];
    const float* norm_mix = args.in[7]; const float* w_in = args.in[8]; const float* conv_w = args.in[9]; const float* conv_b = args.in[10];
    const float* w_rg_a = args.in[11]; const float* b_rg_a = args.in[12]; const float* w_rg_i = args.in[13]; const float* b_rg_i = args.in[14];
    const float* lru_lambda = args.in[15]; const float* w_pool = args.in[16]; const float* b_pool = args.in[17]; const float* pool_scale = args.in[18];
    const float* w_out = args.in[19]; const float* norm_ple = args.in[20]; const float* w_ple_gate = args.in[21]; const float* w_ple = args.in[22]; const float* final_norm = args.in[23];
    float* out = args.out;
    bf16_t* Wt_in = (bf16_t*)(ws + WS_WIN); bf16_t* Wt_out = (bf16_t*)(ws + WS_WOUT); bf16_t* Wt_pg = (bf16_t*)(ws + WS_WPG); bf16_t* Wt_pe = (bf16_t*)(ws + WS_WPE);
    bf16_t* PB = (bf16_t*)(ws + WS_PB); bf16_t* U = (bf16_t*)(ws + WS_U); bf16_t* MERGED = (bf16_t*)(ws + WS_MERGED);
    float* SS2 = (float*)(ws + WS_SS2); float* SS3 = (float*)(ws + WS_SS3);
    bf16_t* PROJ = (bf16_t*)(ws + WS_PROJ); bf16_t* X2B = (bf16_t*)(ws + WS_X2B); bf16_t* PE = (bf16_t*)(ws + WS_PE);
    const int lo = args.ph_lo, hi = args.ph_hi;
#define IN(k) (lo <= (k) && (k) < hi)
#define BOTH(k) (IN(k) && IN((k) + 1))
#define GRID_BAR() do { cg::this_grid().sync(); } while (0)

    if (IN(0)) {
        LAS float* scr = (LAS float*)(lds + wave * 16384);
        constexpr int I_IN = (D / 64) * (INC / 32), I_SQ = (D / 64) * (D / 32), I_PE = (DPLE / 64) * (D / 32);
        constexpr int NITEMS = I_IN + 2 * I_SQ + I_PE;
        for (int it = gw; it < NITEMS; it += NGW) {
            int r = it;
            if (r < I_IN) { p0_transpose_item(w_in, D, INC, Wt_in, norm_mix, scr, r, lane); continue; } r -= I_IN;
            if (r < I_SQ) { p0_transpose_item(w_out, D, D, Wt_out, nullptr, scr, r, lane); continue; } r -= I_SQ;
            if (r < I_SQ) { p0_transpose_item(w_ple_gate, D, D, Wt_pg, norm_ple, scr, r, lane); continue; } r -= I_SQ;
            p0_transpose_item(w_ple, DPLE, D, Wt_pe, nullptr, scr, r, lane);
        }
        for (int m = gw; m < M; m += NGW) {
            const float* xrow = (m < NP) ? x_prompt + (size_t)m * D : x_sample + (size_t)(m - NP) * D;
            const f32x4* xr = (const f32x4*)xrow + lane;
            f32x4 v[4]; float s = 0.f;
#pragma unroll
            for (int j = 0; j < 4; ++j) { v[j] = xr[64 * j]; s += (v[j][0] * v[j][0] + v[j][1] * v[j][1]) + (v[j][2] * v[j][2] + v[j][3] * v[j][3]); }
            const float rstd = 1.0f / sqrtf(wave_sum(s) * (1.0f / D) + EPS);
            u32x2* o8 = (u32x2*)(U + (size_t)m * D) + lane;
#pragma unroll
            for (int j = 0; j < 4; ++j) { u32x2 w; w.x = pk2(v[j][0] * rstd, v[j][1] * rstd); w.y = pk2(v[j][2] * rstd, v[j][3] * rstd); o8[64 * j] = w; }
        }
        {
            const size_t nvec = (size_t)M * DPLE / 8, npv = (size_t)NP * DPLE / 8;
            for (size_t i = (size_t)bid * (NWAVES * 64) + tid; i < nvec; i += (size_t)G * NWAVES * 64) {
                const f32x4* src = (i < npv) ? (const f32x4*)p_prompt + 2 * i : (const f32x4*)p_sample + 2 * (i - npv);
                const f32x4 a = src[0], b = src[1];
                u32x4 w; w.x = pk2(a[0], a[1]); w.y = pk2(a[2], a[3]); w.z = pk2(b[0], b[1]); w.w = pk2(b[2], b[3]);
                ((u32x4*)PB)[i] = w;
            }
        }
        if (BOTH(0)) GRID_BAR();
    }

    if (IN(1)) {
        pg8::Gemm g{U, Wt_in, M, INC, D}; pg8::StaticOrder S; S.init(M, INC, G, bid);
        pg8::EpiBf16 E{PROJ, INC};
        pg8::gemm_phase<pg8::EpiBf16, pg8::StaticOrder, true, true>(lds, g, S, E);
        if (BOTH(1)) GRID_BAR();
    }

    if (IN(2)) {
        const int it = wave * 256 + bid;
        if (wave < 3 && bid < 256) {
            const bool prm = it < 256;
            const int b = prm ? (it >> 4) : ((it - 256) >> 4), h = it & 15;
            const int T = prm ? SEQ : DS; const int row0 = prm ? b * SEQ : NP + b * DS; const int pos0 = prm ? 0 : PAST;
            const int d = h * 64 + lane, g = h >> 2, jo = (h & 3) * 64 + lane, w = 2 << g;
            float wa[64], wi[64];
#pragma unroll
            for (int k = 0; k < 64; ++k) { wa[k] = w_rg_a[(size_t)(h * 64 + k) * 64 + lane]; wi[k] = w_rg_i[(size_t)(h * 64 + k) * 64 + lane]; }
            const float cw0 = conv_w[0 * D + d], cw1 = conv_w[1 * D + d], cw2 = conv_w[2 * D + d], cw3 = conv_w[3 * D + d], cb = conv_b[d];
            const float ba = b_rg_a[d], bi = b_rg_i[d];
            const float lam = lru_lambda[d]; const float nl = -lam; const float sp = fmaxf(nl, 0.f) + log1pf(expf(-fabsf(nl)));
            const float bp = b_pool[g * 256 + jo], psc = pool_scale[d];
            const float* wp = w_pool + (size_t)g * 128 * 256 + jo;
            float z1 = 0.f, z2 = 0.f, z3 = 0.f, hst = 0.f;
            float ra[15], rb[15];
#pragma unroll
            for (int k = 0; k < 15; ++k) { ra[k] = 0.f; rb[k] = 0.f; }
            if (!prm) {
                z3 = state_conv[((size_t)b * 3 + 0) * D + d]; z2 = state_conv[((size_t)b * 3 + 1) * D + d]; z1 = state_conv[((size_t)b * 3 + 2) * D + d];
                hst = state_lru[(size_t)b * D + d];
#pragma unroll
                for (int k = 0; k < 15; ++k) { ra[k] = state_pool[((size_t)b * 15 + (14 - k)) * DPOOL + g * 128 + lane]; rb[k] = state_pool[((size_t)b * 15 + (14 - k)) * DPOOL + g * 128 + 64 + lane]; }
            }
            for (int t = 0; t < T; ++t) {
                const bf16_t* pr = PROJ + (size_t)(row0 + t) * INC;
                const float xl = bf2f(pr[C_XL + d]), gl = bf2f(pr[C_GL + d]), ml = bf2f(pr[C_ML + d]), gp = bf2f(pr[C_GP + d]), mp = bf2f(pr[C_MP + d]);
                const float za = bf2f(pr[C_XP + g * 128 + lane]), zb = bf2f(pr[C_XP + g * 128 + 64 + lane]);
                const float xc = cw0 * z3 + cw1 * z2 + cw2 * z1 + cw3 * xl + cb;
                z3 = z2; z2 = z1; z1 = xl;
                float pra = ba, pri = bi;
#pragma unroll
                for (int k = 0; k < 64; ++k) { const float s = __int_as_float(__builtin_amdgcn_readlane(__float_as_int(xc), k)); pra += s * wa[k]; pri += s * wi[k]; }
                const float r = sigm(pra), ig = sigm(pri);
                const float log_a = -8.0f * r * sp; const float a = __expf(log_a);
                float mult = sqrtf(one_minus_exp(2.0f * log_a)); if (pos0 + t == 0) mult = 1.0f;
                hst = a * hst + mult * (ig * xc);
                const float lru_out = hst * (gl * sigm(gl));
                float sa = za, sb = zb;
#pragma unroll
                for (int k = 0; k < 15; ++k) if (k < w - 1) { sa += ra[k]; sb += rb[k]; }
                const int pos = pos0 + t; const float cnt = (float)((pos + 1 < w) ? pos + 1 : w);
                const float pa = sa / cnt - za, pb_ = sb / cnt - zb;
#pragma unroll
                for (int k = 14; k > 0; --k) { ra[k] = ra[k - 1]; rb[k] = rb[k - 1]; }
                ra[0] = za; rb[0] = zb;
                float pg = bp;
#pragma unroll 16
                for (int k = 0; k < 64; ++k) { const float s = __int_as_float(__builtin_amdgcn_readlane(__float_as_int(pa), k)); pg += s * wp[(size_t)k * 256]; }
#pragma unroll 16
                for (int k = 0; k < 64; ++k) { const float s = __int_as_float(__builtin_amdgcn_readlane(__float_as_int(pb_), k)); pg += s * wp[(size_t)(64 + k) * 256]; }
                const float pool_out = pg * psc * (gp * sigm(gp));
                const float merged = sigm(ml) * lru_out + sigm(mp) * pool_out;
                MERGED[(size_t)(row0 + t) * D + d] = (bf16_t)f2bf(merged);
            }
            float* oc = out + (prm ? O_CONV_P : O_CONV_S) + (size_t)b * 3 * D + d;
            oc[0] = z3; oc[D] = z2; oc[2 * D] = z1;
            out[(prm ? O_LRU_P : O_LRU_S) + (size_t)b * D + d] = hst;
            if ((h & 3) == 0) {
                float* op = out + (prm ? O_POOL_P : O_POOL_S) + (size_t)b * 15 * DPOOL + g * 128 + lane;
#pragma unroll
                for (int k = 0; k < 15; ++k) { op[(size_t)(14 - k) * DPOOL] = ra[k]; op[(size_t)(14 - k) * DPOOL + 64] = rb[k]; }
            }
        }
        if (BOTH(2)) GRID_BAR();
    }

    if (IN(3)) {
        { pg8::Gemm g{MERGED, Wt_out, M, D, D}; pg8::StaticOrder S; S.init(M, D, G, bid);
          pg8::EpiRes1 E{x_prompt, x_sample, out + O_Y, X2B, SS2};
          pg8::gemm_phase<pg8::EpiRes1, pg8::StaticOrder, true, true>(lds, g, S, E); }
        { pg8::Gemm g{PB, Wt_pe, M, D, DPLE}; pg8::StaticOrder S; S.init(M, D, G, (bid + 16) & 255);
          pg8::EpiBf16 E{PE, D};
          pg8::gemm_phase<pg8::EpiBf16, pg8::StaticOrder, true, true>(lds, g, S, E); }
        if (BOTH(3)) GRID_BAR();
    }

    if (IN(4)) {
        pg8::Gemm g{X2B, Wt_pg, M, D, D}; pg8::StaticOrder S; S.init(M, D, G, bid);
        pg8::EpiGate E{out + O_Y, PE, SS2, SS3};
        pg8::gemm_phase<pg8::EpiGate, pg8::StaticOrder, true, true>(lds, g, S, E);
        if (BOTH(4)) GRID_BAR();
    }

    if (IN(5)) {
        f32x4 gsc[4];
#pragma unroll
        for (int j = 0; j < 4; ++j) gsc[j] = ((const f32x4*)final_norm)[lane + 64 * j];
        for (int m = gw; m < M; m += NGW) {
            const float pv = (lane < 16) ? SS3[(size_t)m * 16 + lane] : 0.f;
            const float rstd = 1.0f / sqrtf(wave_sum(pv) * (1.0f / D) + EPS);
            f32x4* yr = (f32x4*)(out + O_Y + (size_t)m * D) + lane;
#pragma unroll
            for (int j = 0; j < 4; ++j) { f32x4 v = yr[64 * j]; v = v * rstd * gsc[j]; yr[64 * j] = v; }
        }
    }
#undef IN
#undef BOTH
#undef GRID_BAR
}

extern "C" void kernel_launch(void* const* d_in, const int* in_sizes, int n_in, void* d_out, int out_size, void* d_ws, size_t ws_size, hipStream_t stream) {
    static int grid = 0;
    if (grid == 0) {
        if (n_in != 24 || (size_t)out_size != O_END || ws_size < WS_END) { fprintf(stderr, "kernel_launch: unexpected shapes: n_in %d out %d ws %zu\n", n_in, out_size, ws_size); grid = -1; return; }
        if (hipFuncSetAttribute((const void*)fwd, hipFuncAttributeMaxDynamicSharedMemorySize, LDS_BYTES) != hipSuccess) { fprintf(stderr, "kernel_launch: hipFuncSetAttribute failed\n"); grid = -1; return; }
        int dev = 0, cus = 0, per_cu = 0;
        (void)hipGetDevice(&dev); (void)hipDeviceGetAttribute(&cus, hipDeviceAttributeMultiprocessorCount, dev);
        (void)hipOccupancyMaxActiveBlocksPerMultiprocessor(&per_cu, (const void*)fwd, NWAVES * 64, LDS_BYTES);
        (void)hipGetLastError();
        if (cus != 256 || per_cu < 1) { fprintf(stderr, "kernel_launch: built for 256 CUs x 1 block; got %d CUs, %d blocks/CU\n", cus, per_cu); grid = -1; return; }
        grid = 256;
    }
    if (grid < 0) return;
    Args a{};
    for (int i = 0; i < 24; ++i) a.in[i] = (const float*)d_in[i];
    a.out = (float*)d_out; a.ws = (unsigned char*)d_ws;
    for (int ph = 0; ph < 6; ++ph) {
        a.ph_lo = ph; a.ph_hi = ph + 1;
        hipLaunchKernelGGL(fwd, dim3(grid), dim3(NWAVES * 64), LDS_BYTES, stream, a);
    }
}
```

```cpp
#include <hip/hip_runtime.h>
#include <hip/hip_cooperative_groups.h>
#include <cstdio>
#include <cstdint>
namespace cg = cooperative_groups;

#define LAS __attribute__((address_space(3)))
typedef unsigned short bf16_t;
typedef short bf16x8 __attribute__((ext_vector_type(8)));
typedef float f32x4 __attribute__((ext_vector_type(4)));
typedef float f32x2 __attribute__((ext_vector_type(2)));
typedef unsigned u32x4 __attribute__((ext_vector_type(4)));
typedef unsigned u32x2 __attribute__((ext_vector_type(2)));

constexpr int D = 1024, SEQ = 2048, NB = 16, DB = 32, DS = 32;
constexpr int NP = NB * SEQ;
constexpr int NS = DB * DS;
constexpr int M = NP + NS;
constexpr int INC = 5632, DPLE = 256, DPOOL = 512;
constexpr int C_XL = 0, C_GL = 1024, C_XP = 2048, C_GP = 2560, C_ML = 3584, C_MP = 4608;
constexpr int PC = 3584, P_XL = 0, P_XP = 1024, P_FL = 1536, P_FP = 2560;
constexpr float EPS = 1e-6f;
constexpr int PAST = 2048;

constexpr size_t MiB = 1u << 20;
constexpr size_t WS_CTL = 0, CTL_ZERO_BYTES = 32 * 1024;
constexpr size_t WS_WIN = 1 * MiB;
constexpr size_t WS_WOUT = 12 * MiB;
constexpr size_t WS_WPG = 14 * MiB;
constexpr size_t WS_WPE = 16 * MiB;
constexpr size_t WS_WRA = 16 * MiB + 512 * 1024;
constexpr size_t WS_WRI = WS_WRA + 128 * 1024;
constexpr size_t WS_WPOOL = WS_WRI + 128 * 1024;
constexpr size_t WS_PB = 17 * MiB;
constexpr size_t WS_U = 34 * MiB;
constexpr size_t WS_MERGED = 340 * MiB;
constexpr size_t WS_C7 = 104 * MiB;
constexpr size_t WS_RS = 103 * MiB;
constexpr size_t WS_SS2 = 100 * MiB;
constexpr size_t WS_SS3 = 103 * MiB;
constexpr size_t WS_PROJ = 106 * MiB;
constexpr size_t WS_X2B = WS_PROJ;
constexpr size_t WS_PE = WS_PROJ + 66 * MiB;
constexpr size_t WS_GPRE = WS_PROJ + 132 * MiB;
constexpr size_t WS_END = 469 * MiB;
static_assert(WS_PROJ + (size_t)M * PC * 2 <= WS_END, "ws map");

constexpr size_t O_Y = 0;
constexpr size_t O_CONV_P = (size_t)M * D;
constexpr size_t O_LRU_P = O_CONV_P + (size_t)NB * 3 * D;
constexpr size_t O_POOL_P = O_LRU_P + (size_t)NB * D;
constexpr size_t O_CONV_S = O_POOL_P + (size_t)NB * 15 * DPOOL;
constexpr size_t O_LRU_S = O_CONV_S + (size_t)DB * 3 * D;
constexpr size_t O_POOL_S = O_LRU_S + (size_t)DB * D;
constexpr size_t O_END = O_POOL_S + (size_t)DB * 15 * DPOOL;

#ifndef REP_P0
#define REP_P0 1
#endif
#ifndef REP_P1
#define REP_P1 1
#endif
#ifndef REP_P2
#define REP_P2 1
#endif
#ifndef REP_P3
#define REP_P3 1
#endif
constexpr int NWAVES = 8;
constexpr int LDS_BYTES = 147456;

namespace pg8 {
constexpr int BM = 256, BK = 64, HALF = 128, HTB = HALF * BK * 2, STAGE_BYTES = 8 * HTB, NXCD = 8, WGM = 8;
__host__ __device__ __forceinline__ int lds_byte(int r, int c) { const int st = (r >> 4) * 2 + (c >> 5), rr = r & 15, cc = c & 31, ob = rr * 64 + cc * 2; return st * 1024 + (ob ^ (((ob >> 9) & 1) << 5)); }
__host__ __device__ __forceinline__ void stage_rc(int b, int& R, int& C) { const int st = b / 1024, sb = b % 1024, swz = sb ^ (((sb >> 9) & 1) << 5); R = (st >> 1) * 16 + swz / 64; C = (st & 1) * 32 + (swz % 64) / 2; }
__host__ __device__ __forceinline__ int perm32(int rho) { const int n = rho >> 4, i = rho & 15; return 8 * (i >> 2) + 4 * n + (i & 3); }

struct Unit { int pm, pn, hoff, half; };
struct Gemm { const bf16_t* A; const bf16_t* Bt; int M, N, K; };

struct StaticOrder {
    int nM, nN, nwg, G, c;
    __host__ __device__ void init(int M_, int N_, int G_, int c_) { nM = M_ / BM; nN = N_ / BM; nwg = nM * nN; G = G_; c = c_; }
    __host__ __device__ bool next(int i, Unit& u) const {
        const long L = (long)i * G + c; if (L >= nwg) return false;
        int wgid = (int)L; { const int q = nwg / NXCD, r = nwg % NXCD, xcd = wgid % NXCD, off = wgid / NXCD; wgid = (xcd < r ? xcd * (q + 1) : r * (q + 1) + (xcd - r) * q) + off; }
        const int nig = WGM * nN, gid = wgid / nig, fm = gid * WGM, gsz = (nM - fm) < WGM ? (nM - fm) : WGM;
        u.pm = fm + ((wgid % nig) % gsz); u.pn = (wgid % nig) / gsz; u.hoff = 0; u.half = 0; return true;
    }
    __device__ __forceinline__ void a_ready(const Unit&) const {}
    __device__ __forceinline__ void done(const Unit&) const {}
};

typedef __bf16 bf16x2_n __attribute__((ext_vector_type(2)));
__device__ __forceinline__ unsigned cvt_pk_bf16(float lo, float hi) { const f32x2 v = {lo, hi}; return __builtin_bit_cast(unsigned, __builtin_convertvector(v, bf16x2_n)); }

struct EpiBf16 {
    static constexpr bool PERM = true, AFTER_DRAIN = false;
    bf16_t* O; int ldc;
    template <bool HM> __device__ __forceinline__ void init(f32x4 (&acc)[2][2][4][2], const Unit&, int, int, int, int) const {
#pragma unroll
        for (int a = 0; a < 2; ++a)
#pragma unroll
            for (int b = 0; b < 2; ++b)
#pragma unroll
                for (int m = 0; m < 4; ++m)
#pragma unroll
                    for (int n = 0; n < 2; ++n) acc[a][b][m][n] = (f32x4){0.f, 0.f, 0.f, 0.f};
    }
    template <bool HM> __device__ __forceinline__ void store(const f32x4 (&acc)[2][2][4][2], const Unit& u, int wr, int wc, int fr, int fq) const {
        const int row0 = u.pm * BM + u.hoff + wr * 64 + fr; const int col0 = u.pn * BM + wc * 32 + 8 * fq;
#pragma unroll
        for (int ai = 0; ai < 2; ++ai) if (!(HM && ai == 1 && u.half))
#pragma unroll
            for (int m = 0; m < 4; ++m) { bf16_t* rowp = O + (size_t)(row0 + ai * HALF + m * 16) * ldc + col0;
#pragma unroll
                for (int bj = 0; bj < 2; ++bj) { const f32x4 v0 = acc[ai][bj][m][0], v1 = acc[ai][bj][m][1];
                    u32x4 w; w.x = cvt_pk_bf16(v0[0], v0[1]); w.y = cvt_pk_bf16(v0[2], v0[3]); w.z = cvt_pk_bf16(v1[0], v1[1]); w.w = cvt_pk_bf16(v1[2], v1[3]);
                    *(u32x4*)(rowp + bj * HALF) = w; } }
    }
};
struct EpiProj {
    static constexpr bool PERM = true, AFTER_DRAIN = false;
    bf16_t* O;
    template <bool HM> __device__ __forceinline__ void init(f32x4 (&acc)[2][2][4][2], const Unit&, int, int, int, int) const {
#pragma unroll
        for (int a = 0; a < 2; ++a)
#pragma unroll
            for (int b = 0; b < 2; ++b)
#pragma unroll
                for (int m = 0; m < 4; ++m)
#pragma unroll
                    for (int n = 0; n < 2; ++n) acc[a][b][m][n] = (f32x4){0.f, 0.f, 0.f, 0.f};
    }
    static __device__ __forceinline__ unsigned gate2pk(float ga, float gb, float ma, float mb) {
        const f32x2 g = (f32x2){ga, gb}; const f32x2 t = g * -1.44269504088896341f;
        const f32x2 dg = (f32x2){__builtin_amdgcn_exp2f(t[0]), __builtin_amdgcn_exp2f(t[1])} + 1.0f, dm = (f32x2){__builtin_amdgcn_exp2f(ma), __builtin_amdgcn_exp2f(mb)} + 1.0f;
        const f32x2 den = dg * dm; const f32x2 f = g * (f32x2){__builtin_amdgcn_rcpf(den[0]), __builtin_amdgcn_rcpf(den[1])};
        return cvt_pk_bf16(f[0], f[1]);
    }
    template <bool HM> __device__ __forceinline__ void store(const f32x4 (&acc)[2][2][4][2], const Unit& u, int wr, int wc, int fr, int fq) const {
        const int row0 = u.pm * BM + u.hoff + wr * 64 + fr;
        if (u.pn < 4) {
            bf16_t* base = O + (size_t)M * P_XL + ((size_t)(4 * u.pn + (wc >> 1)) * M + row0) * 64 + 32 * (wc & 1) + 8 * fq;
#pragma unroll
            for (int ai = 0; ai < 2; ++ai) if (!(HM && ai == 1 && u.half))
#pragma unroll
                for (int m = 0; m < 4; ++m)
#pragma unroll
                    for (int bj = 0; bj < 2; ++bj) { const f32x4 v0 = acc[ai][bj][m][0], v1 = acc[ai][bj][m][1];
                        u32x4 w; w.x = cvt_pk_bf16(v0[0], v0[1]); w.y = cvt_pk_bf16(v0[2], v0[3]); w.z = cvt_pk_bf16(v1[0], v1[1]); w.w = cvt_pk_bf16(v1[2], v1[3]);
                        __builtin_nontemporal_store(w, (u32x4*)(base + ((size_t)(2 * bj) * M + ai * HALF + m * 16) * 64)); }
        } else if (u.pn < 6) {
            bf16_t* base = O + (size_t)M * P_XP + ((size_t)(2 * (u.pn - 4)) * M + row0) * 128 + 32 * wc + 8 * fq;
#pragma unroll
            for (int ai = 0; ai < 2; ++ai) if (!(HM && ai == 1 && u.half))
#pragma unroll
                for (int m = 0; m < 4; ++m)
#pragma unroll
                    for (int bj = 0; bj < 2; ++bj) { const f32x4 v0 = acc[ai][bj][m][0], v1 = acc[ai][bj][m][1];
                        u32x4 w; w.x = cvt_pk_bf16(v0[0], v0[1]); w.y = cvt_pk_bf16(v0[2], v0[3]); w.z = cvt_pk_bf16(v1[0], v1[1]); w.w = cvt_pk_bf16(v1[2], v1[3]);
                        __builtin_nontemporal_store(w, (u32x4*)(base + ((size_t)bj * M + ai * HALF + m * 16) * 128)); }
        } else {
            const int q = u.pn - 6;
            bf16_t* base = O + (size_t)M * (P_FL + (q >> 3) * 1024) + ((size_t)(2 * (q & 7) + (wc >> 1)) * M + row0) * 64 + 32 * (wc & 1) + 8 * fq;
#pragma unroll
            for (int ai = 0; ai < 2; ++ai) if (!(HM && ai == 1 && u.half))
#pragma unroll
                for (int m = 0; m < 4; ++m) {
                    const f32x4 g0 = acc[ai][0][m][0], g1 = acc[ai][0][m][1], m0 = acc[ai][1][m][0], m1 = acc[ai][1][m][1];
                    u32x4 w; w.x = gate2pk(g0[0], g0[1], m0[0], m0[1]); w.y = gate2pk(g0[2], g0[3], m0[2], m0[3]);
                    w.z = gate2pk(g1[0], g1[1], m1[0], m1[1]); w.w = gate2pk(g1[2], g1[3], m1[2], m1[3]);
                    __builtin_nontemporal_store(w, (u32x4*)(base + (size_t)(ai * HALF + m * 16) * 64)); }
        }
    }
};
struct EpiRes1 {
    static constexpr bool PERM = true, AFTER_DRAIN = false;
    const bf16_t* U; const float* rs; bf16_t* x2b; float* ss;
    template <bool HM> __device__ __forceinline__ void init(f32x4 (&acc)[2][2][4][2], const Unit& u, int wr, int wc, int fr, int fq) const {
        const bf16_t* ub = U + (size_t)(u.pm * BM + u.hoff) * D + u.pn * BM;
        const unsigned loff = (unsigned)((wr * 64 + fr) * D + wc * 32 + 8 * fq);
        const float* rsb = rs + u.pm * BM + u.hoff + wr * 64 + fr;
        if (HM && u.half) {
#pragma unroll
            for (int b = 0; b < 2; ++b)
#pragma unroll
                for (int m = 0; m < 4; ++m)
#pragma unroll
                    for (int n = 0; n < 2; ++n) acc[1][b][m][n] = (f32x4){0.f, 0.f, 0.f, 0.f};
        }
#pragma unroll
        for (int ai = 0; ai < 2; ++ai) if (!(HM && ai == 1 && u.half))
#pragma unroll
            for (int m = 0; m < 4; ++m) { const bf16_t* rb = ub + (ai * HALF + m * 16) * D; const float r = rsb[ai * HALF + m * 16];
#pragma unroll
                for (int bj = 0; bj < 2; ++bj) { const u32x4 w = __builtin_nontemporal_load((const u32x4*)(rb + loff + bj * HALF));
                    acc[ai][bj][m][0] = (f32x4){__uint_as_float(w.x << 16) * r, __uint_as_float(w.x & 0xffff0000u) * r, __uint_as_float(w.y << 16) * r, __uint_as_float(w.y & 0xffff0000u) * r};
                    acc[ai][bj][m][1] = (f32x4){__uint_as_float(w.z << 16) * r, __uint_as_float(w.z & 0xffff0000u) * r, __uint_as_float(w.w << 16) * r, __uint_as_float(w.w & 0xffff0000u) * r}; } }
    }
    template <bool HM> __device__ __forceinline__ void store(const f32x4 (&acc)[2][2][4][2], const Unit& u, int wr, int wc, int fr, int fq) const {
        const int row0 = u.pm * BM + u.hoff + wr * 64 + fr, col0 = u.pn * BM + wc * 32 + 8 * fq;
#pragma unroll
        for (int ai = 0; ai < 2; ++ai) if (!(HM && ai == 1 && u.half))
#pragma unroll
            for (int m = 0; m < 4; ++m) { const int row = row0 + ai * HALF + m * 16; const size_t off = (size_t)row * D + col0; float s = 0.f;
#pragma unroll
                for (int bj = 0; bj < 2; ++bj) { const f32x4 v0 = acc[ai][bj][m][0], v1 = acc[ai][bj][m][1];
                    s += ((v0[0] * v0[0] + v0[1] * v0[1]) + (v0[2] * v0[2] + v0[3] * v0[3])) + ((v1[0] * v1[0] + v1[1] * v1[1]) + (v1[2] * v1[2] + v1[3] * v1[3]));
                    u32x4 w; w.x = cvt_pk_bf16(v0[0], v0[1]); w.y = cvt_pk_bf16(v0[2], v0[3]); w.z = cvt_pk_bf16(v1[0], v1[1]); w.w = cvt_pk_bf16(v1[2], v1[3]);
                    *(u32x4*)(x2b + off + bj * HALF) = w; }
                s += __shfl_xor(s, 16); s += __shfl_xor(s, 32);
                if (fq == 0) ss[(size_t)row * 16 + u.pn * 4 + wc] = s; }
    }
};
struct PanelOrder {
    int c;
    __device__ __forceinline__ bool next(int i, Unit& u) const {
        if (i < 2) { const int xcd = c & 7, slot = c >> 3; u.pm = 64 * i + 8 * xcd + (slot & 7); u.pn = slot >> 3; u.hoff = 0; u.half = 0; return true; }
        return false;
    }
    __device__ __forceinline__ void a_ready(const Unit&) const {}
    __device__ __forceinline__ void done(const Unit&) const {}
};
struct TailOrder {
    int nN, c, count;
    __device__ __forceinline__ bool next(int i, Unit& u) const {
        if (i == 0 && c < count) { const int fu = c >> 1; u.pm = 128 + fu / nN; u.pn = fu % nN; u.hoff = (c & 1) * HALF; u.half = 1; return true; }
        return false;
    }
    __device__ __forceinline__ void a_ready(const Unit&) const {}
    __device__ __forceinline__ void done(const Unit&) const {}
};
struct PanelTail {
    int c;
    __device__ __forceinline__ bool next(int i, Unit& u) const {
        if (i < 2) { const int xcd = c & 7, slot = c >> 3; u.pm = 64 * i + 8 * xcd + (slot & 7); u.pn = slot >> 3; u.hoff = 0; u.half = 0; return true; }
        if (i == 2 && c < 32) { const int fu = c >> 1; u.pm = 128 + (fu >> 2); u.pn = fu & 3; u.hoff = (c & 1) * HALF; u.half = 1; return true; }
        return false;
    }
    __device__ __forceinline__ void a_ready(const Unit&) const {}
    __device__ __forceinline__ void done(const Unit&) const {}
};
struct PeA {
    int c;
    __device__ __forceinline__ bool next(int i, Unit& u) const {
        if (i == 0 && c >= 32) { const int cc = c - 32, xcd = cc & 7, slot = cc >> 3; u.pm = 8 * xcd + (slot & 7); u.pn = slot >> 3; u.hoff = 0; u.half = 0; return true; }
        return false;
    }
    __device__ __forceinline__ void a_ready(const Unit&) const {}
    __device__ __forceinline__ void done(const Unit&) const {}
};
struct PeB {
    int c;
    static __device__ __forceinline__ void unit_of(int id, Unit& u) { const int i = id >> 8, cc = id & 255, xcd = cc & 7, slot = cc >> 3; u.pm = 64 * i + 8 * xcd + (slot & 7); u.pn = slot >> 3; u.hoff = 0; u.half = 0; }
    __device__ __forceinline__ bool next(int i, Unit& u) const {
        if (c < 32) return false;
        if (i == 0) { unit_of(224 + (c - 32), u); return true; }
        if (i == 1 && c < 96) { unit_of(448 + (c - 32), u); return true; }
        if (i == 1 && c >= 96 && c < 128) { const int t = c - 96, fu = t >> 1; u.pm = 128 + (fu >> 2); u.pn = fu & 3; u.hoff = (t & 1) * HALF; u.half = 1; return true; }
        return false;
    }
    __device__ __forceinline__ void a_ready(const Unit&) const {}
    __device__ __forceinline__ void done(const Unit&) const {}
};
template <class Epi, class Sched, bool ALIGN_EPI = false, bool SP2 = false, bool HALFM = false>
__device__ __forceinline__ void gemm_phase(LAS unsigned char* lds, const Gemm g, const Sched& S, const Epi& E, const int wave_s) {
    int tid; { int l; asm volatile("v_mbcnt_lo_u32_b32 %0, -1, 0\n\tv_mbcnt_hi_u32_b32 %0, -1, %0" : "=v"(l)); tid = wave_s * 64 + l; }
    const int wid = __builtin_amdgcn_readfirstlane(tid >> 6), lane = tid & 63, wr = wid >> 2, wc = wid & 3, fr = lane & 15, fq = lane >> 4;
    const int K = g.K, nt = K / BK;
    unsigned voffA[2], voffB[2];
#pragma unroll
    for (int i = 0; i < 2; ++i) { int R, C; stage_rc(tid * 16 + i * 8192, R, C); const int Rb = Epi::PERM ? ((R & ~31) + perm32(R & 31)) : R;
        voffA[i] = (unsigned)(R * K + C) * 2u; voffB[i] = (unsigned)(Rb * K + C) * 2u; }
    const size_t kstep = (size_t)(BK * 2);
    const size_t hstep = (size_t)HALF * K * 2;
    const size_t tstep = 2 * hstep;
    const unsigned ldsw = (unsigned)wid * 1024u;
    const int aoff = lds_byte(wr * 64 + fr, fq * 8), boff = lds_byte(wc * 32 + fr, fq * 8);
#define PG8_SA(b, h) (((b) * 2 + (h)) * HTB)
#define PG8_SB(b, h) ((4 + (b) * 2 + (h)) * HTB)
#define PG8_STAGE(bufoff, gbase, voff) do { _Pragma("unroll") for (int _i = 0; _i < 2; ++_i) \
        __builtin_amdgcn_global_load_lds((const unsigned*)((const char*)(gbase) + (voff)[_i]), (LAS unsigned*)(lds + (bufoff) + ldsw + _i * 8192), 16, 0, 0); } while (0)
#define PG8_LDA(dst, b, h) do { _Pragma("unroll") for (int m = 0; m < 4; ++m) _Pragma("unroll") for (int k = 0; k < 2; ++k) dst[m][k] = *(const LAS bf16x8*)(lds + PG8_SA(b, h) + aoff + m * 2048 + k * 1024); } while (0)
#define PG8_LDB(dst, b, h) do { _Pragma("unroll") for (int n = 0; n < 2; ++n) _Pragma("unroll") for (int k = 0; k < 2; ++k) dst[n][k] = *(const LAS bf16x8*)(lds + PG8_SB(b, h) + boff + n * 2048 + k * 1024); } while (0)
#define PG8_MMA(ai, bj, At, Bt) do { __builtin_amdgcn_s_setprio(1); _Pragma("unroll") for (int m = 0; m < 4; ++m) _Pragma("unroll") for (int n = 0; n < 2; ++n) _Pragma("unroll") for (int k = 0; k < 2; ++k) \
        acc[ai][bj][m][n] = __builtin_amdgcn_mfma_f32_16x16x32_bf16(Bt[n][k], At[m][k], acc[ai][bj][m][n], 0, 0, 0); __builtin_amdgcn_s_setprio(0); } while (0)
#define PG8_WAIT_V(n) asm volatile("s_waitcnt vmcnt(" #n ")" ::: "memory")
#define PG8_WAIT_L(n) asm volatile("s_waitcnt lgkmcnt(" #n ")" ::: "memory")
#define PG8_BAR __builtin_amdgcn_s_barrier()
#define PG8_SCHED __builtin_amdgcn_sched_barrier(0)
    static_assert(!HALFM || SP2, "half-M units are implemented for the SP2 loop only");
    Unit cur{0, 0, 0, 0}, nxt{0, 0, 0, 0}; int ui = 0;
    if (!S.next(0, cur)) return;
    f32x4 acc[2][2][4][2];
    E.template init<HALFM>(acc, cur, wr, wc, fr, fq);
    bf16x8 At[4][2], B0[2][2], B1[2][2];
    bool chalf = HALFM && cur.half != 0; size_t cahs = chalf ? 0 : hstep;
    const char* cA = (const char*)g.A + (size_t)cur.pm * tstep + (HALFM ? (size_t)cur.hoff * K * 2 : 0); const char* cB = (const char*)g.Bt + (size_t)cur.pn * tstep;
    S.a_ready(cur);
    if constexpr (SP2) {
        PG8_STAGE(PG8_SB(0, 0), cB, voffB); PG8_STAGE(PG8_SB(0, 1), cB + hstep, voffB); PG8_STAGE(PG8_SA(0, 0), cA, voffA); PG8_STAGE(PG8_SA(0, 1), cA + cahs, voffA);
        if (wr == 1) PG8_BAR;
        PG8_WAIT_V(2); PG8_BAR;
        PG8_STAGE(PG8_SB(1, 0), cB + kstep, voffB); PG8_STAGE(PG8_SA(1, 0), cA + kstep, voffA); PG8_STAGE(PG8_SB(1, 1), cB + hstep + kstep, voffB);
        PG8_WAIT_V(6); PG8_BAR;
    } else {
        PG8_STAGE(PG8_SB(0, 0), cB, voffB); PG8_STAGE(PG8_SA(0, 0), cA, voffA); PG8_STAGE(PG8_SB(0, 1), cB + hstep, voffB); PG8_STAGE(PG8_SA(0, 1), cA + cahs, voffA);
        if (wr == 1) PG8_BAR;
        PG8_WAIT_V(4); PG8_BAR;
        PG8_STAGE(PG8_SB(1, 0), cB + kstep, voffB); PG8_STAGE(PG8_SA(1, 0), cA + kstep, voffA); PG8_STAGE(PG8_SB(1, 1), cB + hstep + kstep, voffB);
        PG8_WAIT_V(6); PG8_BAR;
    }
    for (;;) {
        const bool has_next = S.next(ui + 1, nxt);
        const bool nhalf = HALFM && has_next && nxt.half != 0; const size_t nahs = has_next ? (nhalf ? 0 : hstep) : cahs;
        const char* nA = has_next ? (const char*)g.A + (size_t)nxt.pm * tstep + (HALFM ? (size_t)nxt.hoff * K * 2 : 0) : cA; const char* nB = has_next ? (const char*)g.Bt + (size_t)nxt.pn * tstep : cB;
        for (int t = 0; t < nt; t += 2) {
            const bool last = (t == nt - 2);
            const char* a1 = cA + (size_t)(t + 1) * kstep;
            const char* a2 = last ? nA : cA + (size_t)(t + 2) * kstep; const char* b2 = last ? nB : cB + (size_t)(t + 2) * kstep;
            const char* a3 = a2 + kstep; const char* b3 = b2 + kstep; const size_t ahs2 = last ? nahs : cahs;
            if (last && has_next) S.a_ready(nxt);
            if constexpr (SP2) {
            PG8_LDB(B0, 0, 0); PG8_LDB(B1, 0, 1); PG8_SCHED; PG8_LDA(At, 0, 0); PG8_STAGE(PG8_SA(1, 1), a1 + cahs, voffA);
            PG8_WAIT_V(8); PG8_WAIT_L(0); PG8_BAR; PG8_MMA(0, 0, At, B0); PG8_MMA(0, 1, At, B1); PG8_BAR; PG8_SCHED;
            if (!chalf) PG8_LDA(At, 0, 1); PG8_STAGE(PG8_SB(0, 0), b2, voffB); PG8_STAGE(PG8_SB(0, 1), b2 + hstep, voffB); PG8_STAGE(PG8_SA(0, 0), a2, voffA);
            PG8_WAIT_V(8); PG8_WAIT_L(0); PG8_BAR; if (!chalf) { PG8_MMA(1, 0, At, B0); PG8_MMA(1, 1, At, B1); } PG8_BAR; PG8_SCHED;
            PG8_LDB(B0, 1, 0); PG8_LDB(B1, 1, 1); PG8_SCHED; PG8_LDA(At, 1, 0); PG8_STAGE(PG8_SA(0, 1), a2 + ahs2, voffA);
            PG8_WAIT_V(8); PG8_WAIT_L(0); PG8_BAR; PG8_MMA(0, 0, At, B0); PG8_MMA(0, 1, At, B1); PG8_BAR; PG8_SCHED;
            if (!chalf) PG8_LDA(At, 1, 1); PG8_STAGE(PG8_SB(1, 0), b3, voffB); PG8_STAGE(PG8_SB(1, 1), b3 + hstep, voffB); PG8_STAGE(PG8_SA(1, 0), a3, voffA);
            PG8_WAIT_V(8); PG8_WAIT_L(0); PG8_BAR; if (!chalf) { PG8_MMA(1, 0, At, B0); PG8_MMA(1, 1, At, B1); } PG8_BAR; PG8_SCHED;
            } else {
            PG8_LDB(B0, 0, 0); PG8_SCHED; PG8_LDA(At, 0, 0); PG8_STAGE(PG8_SA(1, 1), a1 + cahs, voffA);
            PG8_WAIT_L(8); PG8_BAR; PG8_WAIT_L(0); PG8_MMA(0, 0, At, B0); PG8_BAR; PG8_SCHED;
            PG8_LDB(B1, 0, 1); PG8_STAGE(PG8_SB(0, 0), b2, voffB);
            PG8_BAR; PG8_WAIT_L(0); PG8_MMA(0, 1, At, B1); PG8_BAR;
            PG8_LDA(At, 0, 1); PG8_STAGE(PG8_SA(0, 0), a2, voffA);
            PG8_BAR; PG8_WAIT_L(0); PG8_MMA(1, 0, At, B0); PG8_BAR; PG8_SCHED;
            PG8_STAGE(PG8_SB(0, 1), b2 + hstep, voffB);
            PG8_WAIT_V(6); PG8_BAR; PG8_MMA(1, 1, At, B1); PG8_BAR;
            PG8_LDB(B0, 1, 0); PG8_SCHED; PG8_LDA(At, 1, 0); PG8_STAGE(PG8_SA(0, 1), a2 + ahs2, voffA);
            PG8_WAIT_L(8); PG8_BAR; PG8_WAIT_L(0); PG8_MMA(0, 0, At, B0); PG8_BAR; PG8_SCHED;
            PG8_LDB(B1, 1, 1); PG8_STAGE(PG8_SB(1, 0), b3, voffB);
            PG8_BAR; PG8_WAIT_L(0); PG8_MMA(0, 1, At, B1); PG8_BAR;
            PG8_LDA(At, 1, 1); PG8_STAGE(PG8_SA(1, 0), a3, voffA);
            PG8_BAR; PG8_WAIT_L(0); PG8_MMA(1, 0, At, B0); PG8_BAR; PG8_SCHED;
            PG8_STAGE(PG8_SB(1, 1), b3 + hstep, voffB);
            PG8_WAIT_V(6); PG8_BAR; PG8_MMA(1, 1, At, B1); PG8_BAR;
            }
        }
        if constexpr (ALIGN_EPI) { if (wr == 0) PG8_BAR; }
        E.template store<HALFM>(acc, cur, wr, wc, fr, fq); S.done(cur);
        if (!has_next) break;
        E.template init<HALFM>(acc, nxt, wr, wc, fr, fq);
        cur = nxt; cA = nA; cB = nB; ++ui; chalf = nhalf; cahs = nahs;
        if constexpr (ALIGN_EPI) { if (wr == 1) PG8_BAR; }
    }
    PG8_WAIT_V(0);
    if constexpr (!ALIGN_EPI) { if (wr == 0) PG8_BAR; }
    PG8_BAR;
#undef PG8_SA
#undef PG8_SB
#undef PG8_STAGE
#undef PG8_LDA
#undef PG8_LDB
#undef PG8_MMA
#undef PG8_WAIT_V
#undef PG8_WAIT_L
#undef PG8_BAR
#undef PG8_SCHED
}
}

__device__ __forceinline__ int lane_id_asm() { int l; asm volatile("v_mbcnt_lo_u32_b32 %0, -1, 0\n\tv_mbcnt_hi_u32_b32 %0, -1, %0" : "=v"(l)); return l; }
__device__ __forceinline__ int opaque_tid(int wave_s) { return wave_s * 64 + lane_id_asm(); }
#define LDS_WAIT() asm volatile("s_waitcnt lgkmcnt(0)" ::: "memory")
__device__ __forceinline__ unsigned f2bf(float f) { unsigned u = __float_as_uint(f); return (u + 0x7fffu + ((u >> 16) & 1u)) >> 16; }
__device__ __forceinline__ unsigned pk2(float lo, float hi) { return pg8::cvt_pk_bf16(lo, hi); }
__device__ __forceinline__ float bf2f(bf16_t v) { return __uint_as_float(((unsigned)v) << 16); }
__device__ __forceinline__ float dpp_add(float v, const int ctrl_is) {
    return v;
}
template <int CTRL> __device__ __forceinline__ float dpp_mov(float v) { return __int_as_float(__builtin_amdgcn_update_dpp(0, __float_as_int(v), CTRL, 0xf, 0xf, true)); }
__device__ __forceinline__ float wave_sum(float v) {
    v += dpp_mov<0xB1>(v);
    v += dpp_mov<0x4E>(v);
    v += dpp_mov<0x141>(v);
    v += dpp_mov<0x140>(v);
    v += __shfl_xor(v, 16); v += __shfl_xor(v, 32);
    return v;
}
__device__ __forceinline__ float fexp(float x) { return __builtin_amdgcn_exp2f(x * 1.44269504088896341f); }
__device__ __forceinline__ float sigm(float x) { return __builtin_amdgcn_rcpf(1.0f + fexp(-x)); }
typedef __bf16 bf16x2_t __attribute__((ext_vector_type(2)));
__device__ __forceinline__ unsigned cvt_pk_native(float lo, float hi) { const f32x2 v = {lo, hi}; return __builtin_bit_cast(unsigned, __builtin_convertvector(v, bf16x2_t)); }
__device__ __forceinline__ unsigned short f2bf_hw(float x) { return (unsigned short)pg8::cvt_pk_bf16(x, x); }
__device__ __forceinline__ float one_minus_exp(float x, float e) {
    const float p = -x * (1.0f + x * (0.5f + x * (1.0f / 6.0f + x * (1.0f / 24.0f + x * (1.0f / 120.0f + x * (1.0f / 720.0f))))));
    const float q = 1.0f - e * e;
    return x > -0.25f ? p : q;
}

namespace mx {
constexpr int XS = 144;
constexpr int PS = 272;
constexpr int L_XLR = 0;
constexpr int L_XPR = L_XLR + 144 * XS;
constexpr int L_FL = L_XPR + 144 * PS;
constexpr int L_FP = L_FL + 64 * XS;
constexpr int L_AX = L_FP + 64 * XS;
constexpr int L_AP = L_AX + 2 * 64 * XS;
constexpr int L_OUT = L_AP + 2 * 64 * PS;
constexpr int L_COMP = L_OUT + 64 * XS;
constexpr int L_CARRY = L_COMP + 512;
constexpr int L_END = L_CARRY + 512;
static_assert(L_END <= LDS_BYTES - 256, "mixer LDS map");

#define MX_BAR() do { asm volatile("s_waitcnt lgkmcnt(0)" ::: "memory"); __builtin_amdgcn_s_barrier(); asm volatile("" ::: "memory"); } while (0)

__device__ __forceinline__ float ldbf(const LAS unsigned char* p) { return __uint_as_float(((unsigned)*(const LAS unsigned short*)p) << 16); }
typedef short v4s __attribute__((ext_vector_type(4)));

struct MixP {
    const bf16_t* proj; bf16_t* merged; float* out;
    const float* state_conv; const float* state_lru; const float* state_pool;
    const float* conv_w; const float* conv_b; const float* b_rg_a; const float* b_rg_i; const float* lru_lambda; const float* b_pool; const float* pool_scale;
    const bf16_t* wt_ra; const bf16_t* wt_ri; const bf16_t* wt_pool;
};
struct MixC {
    bf16x8 wfa[2], wfi[2], wfp[4];
    float cw0, cw1, cw2, cw3, cb, ba, bi, c7, bp;
    int hf, fq, fr, nmt, Tc, wave;
    const LAS unsigned char* pxl;
    LAS unsigned char* paxw;
    const LAS unsigned char* paxr;
    const LAS unsigned char* papr;
    const LAS unsigned char* pfl;
    LAS unsigned char* pout;
    bf16x8 bandA; int W;
    const LAS unsigned char* ptr;
    LAS unsigned char* papw;
    LAS unsigned char* pcomp; LAS unsigned char* pcarry;
};
struct MixS2 { float av[2][4], bv[2][4], fl[2][4], pl[2][4], PA[2], PB[2], TA[2], TB[2], AW, BW; };

template <int CB, int PAR>
__device__ __forceinline__ void mixer_s1(const MixC& C, const int posc, float (&xc)[2][4]) {
    const int hf = C.hf;
    unsigned short xr[2][7];
#pragma unroll
    for (int mi = 0; mi < 2; ++mi)
#pragma unroll
        for (int i = 0; i < 7; ++i) xr[mi][i] = *(const LAS unsigned short*)(C.pxl + (CB + 16 * mi + i - 3) * XS);
    v4s lo[4], hi[4];
#pragma unroll
    for (int nn = 0; nn < 4; ++nn) { lo[nn] = __builtin_amdgcn_ds_read_tr16_b64_v4i16((LAS v4s*)(C.ptr + (CB - 16) * PS + 32 * nn)); hi[nn] = __builtin_amdgcn_ds_read_tr16_b64_v4i16((LAS v4s*)(C.ptr + (CB - 12) * PS + 32 * nn)); }
    asm volatile("s_waitcnt lgkmcnt(0)" ::: "memory");
    bf16x8 bA = C.bandA;
    if (posc == 0 && (C.wave & 3) == 0) {
        const int cn = (C.fr + 1 < C.W) ? C.fr + 1 : C.W; const float rc = __builtin_amdgcn_rcpf((float)cn); short bw[8];
#pragma unroll
        for (int jj = 0; jj < 8; ++jj) { const int dd = C.fr + 16 - (8 * C.fq + jj); const float cf = ((dd >= 0 && dd < C.W) ? rc : 0.f) - (dd == 0 ? 1.0f : 0.f); bw[jj] = (short)f2bf_hw(cf); }
        bA = (bf16x8){bw[0], bw[1], bw[2], bw[3], bw[4], bw[5], bw[6], bw[7]};
    }
    f32x4 q[4];
#pragma unroll
    for (int nn = 0; nn < 4; ++nn) { const bf16x8 zf = (bf16x8){lo[nn][0], lo[nn][1], lo[nn][2], lo[nn][3], hi[nn][0], hi[nn][1], hi[nn][2], hi[nn][3]};
        q[nn] = __builtin_amdgcn_mfma_f32_16x16x32_bf16(bA, zf, (f32x4){0.f, 0.f, 0.f, 0.f}, 0, 0, 0); }
#pragma unroll
    for (int mi = 0; mi < 2; ++mi) if (2 * hf + mi < C.nmt) {
        float xv[7];
#pragma unroll
        for (int i = 0; i < 7; ++i) xv[i] = __uint_as_float(((unsigned)xr[mi][i]) << 16);
#pragma unroll
        for (int j = 0; j < 4; j += 2) {
            f32x2 a = (f32x2){xv[j], xv[j + 1]} * C.cw0 + C.cb;
            a = (f32x2){xv[j + 1], xv[j + 2]} * C.cw1 + a; a = (f32x2){xv[j + 2], xv[j + 3]} * C.cw2 + a; a = (f32x2){xv[j + 3], xv[j + 4]} * C.cw3 + a;
            xc[mi][j] = a[0]; xc[mi][j + 1] = a[1];
            const unsigned pk = pg8::cvt_pk_bf16(a[0], a[1]);
            *(LAS unsigned short*)(C.paxw + PAR * 64 * XS + (16 * mi + j) * XS) = (unsigned short)pk; *(LAS unsigned short*)(C.paxw + PAR * 64 * XS + (16 * mi + j + 1) * XS) = (unsigned short)(pk >> 16); }
    }
    if (16 * (C.wave & 3) < C.Tc) {
#pragma unroll
        for (int nn = 0; nn < 4; ++nn) {
            const unsigned p01 = pg8::cvt_pk_bf16(q[nn][0], q[nn][1]), p23 = pg8::cvt_pk_bf16(q[nn][2], q[nn][3]);
            LAS unsigned char* pw = C.papw + PAR * 64 * PS + 32 * nn;
            *(LAS unsigned short*)(pw) = (unsigned short)p01; *(LAS unsigned short*)(pw + PS) = (unsigned short)(p01 >> 16);
            *(LAS unsigned short*)(pw + 2 * PS) = (unsigned short)p23; *(LAS unsigned short*)(pw + 3 * PS) = (unsigned short)(p23 >> 16);
        }
    }
}

template <int PAR>
__device__ __forceinline__ void mixer_s2(const MixC& C, const int posc, const float (&xc)[2][4], MixS2& R) {
    const int hf = C.hf, fq = C.fq;
    bf16x8 afx[2][2], afp[2][4]; unsigned flr[2][4], fpr[2][4]; float LA[2], LB[2];
#pragma unroll
    for (int mi = 0; mi < 2; ++mi) {
#pragma unroll
        for (int ks = 0; ks < 2; ++ks) afx[mi][ks] = *(const LAS bf16x8*)(C.paxr + PAR * 64 * XS + 16 * mi * XS + 64 * ks);
#pragma unroll
        for (int ks = 0; ks < 4; ++ks) afp[mi][ks] = *(const LAS bf16x8*)(C.papr + PAR * 64 * PS + 16 * mi * PS + 64 * ks);
#pragma unroll
        for (int j = 0; j < 4; ++j) { flr[mi][j] = *(const LAS unsigned short*)(C.pfl + (16 * mi + j) * XS); fpr[mi][j] = *(const LAS unsigned short*)(C.pfl + (L_FP - L_FL) + (16 * mi + j) * XS); }
    }
    asm volatile("s_waitcnt lgkmcnt(0)" ::: "memory");
#pragma unroll
    for (int mi = 0; mi < 2; ++mi) {
        f32x4 accA = (f32x4){0.f, 0.f, 0.f, 0.f}, accB = accA, accP = accA;
#pragma unroll
        for (int ks = 0; ks < 2; ++ks) {
            accA = __builtin_amdgcn_mfma_f32_16x16x32_bf16(afx[mi][ks], C.wfa[ks], accA, 0, 0, 0);
            accB = __builtin_amdgcn_mfma_f32_16x16x32_bf16(afx[mi][ks], C.wfi[ks], accB, 0, 0, 0); }
#pragma unroll
        for (int ks = 0; ks < 4; ++ks) accP = __builtin_amdgcn_mfma_f32_16x16x32_bf16(afp[mi][ks], C.wfp[ks], accP, 0, 0, 0);
#pragma unroll
        for (int j = 0; j < 4; j += 2) {
            const f32x2 za = (f32x2){accA[j], accA[j + 1]} + C.ba, zi = (f32x2){accB[j], accB[j + 1]} + C.bi;
            const f32x2 da = (f32x2){__builtin_amdgcn_exp2f(za[0]), __builtin_amdgcn_exp2f(za[1])} + 1.0f, di = (f32x2){__builtin_amdgcn_exp2f(zi[0]), __builtin_amdgcn_exp2f(zi[1])} + 1.0f;
            const f32x2 r = (f32x2){__builtin_amdgcn_rcpf(da[0]), __builtin_amdgcn_rcpf(da[1])}, ig = (f32x2){__builtin_amdgcn_rcpf(di[0]), __builtin_amdgcn_rcpf(di[1])};
            const f32x2 la = r * C.c7;
            const f32x2 a = (f32x2){__builtin_amdgcn_exp2f(la[0]), __builtin_amdgcn_exp2f(la[1])};
            const f32x2 om = 1.0f - a * a;
            f32x2 mult = (f32x2){__builtin_amdgcn_sqrtf(om[0]), __builtin_amdgcn_sqrtf(om[1])};
            if (mi == 0 && j == 0) mult[0] = (posc == 0 && hf == 0 && fq == 0) ? 1.0f : mult[0];
            const f32x2 bq = mult * (ig * (f32x2){xc[mi][j], xc[mi][j + 1]});
            R.av[mi][j] = a[0]; R.av[mi][j + 1] = a[1]; R.bv[mi][j] = bq[0]; R.bv[mi][j + 1] = bq[1];
            R.fl[mi][j] = __uint_as_float(flr[mi][j] << 16); R.fl[mi][j + 1] = __uint_as_float(flr[mi][j + 1] << 16);
            const f32x2 pq = ((f32x2){accP[j], accP[j + 1]} + C.bp) * (f32x2){__uint_as_float(fpr[mi][j] << 16), __uint_as_float(fpr[mi][j + 1] << 16)};
            R.pl[mi][j] = pq[0]; R.pl[mi][j + 1] = pq[1];
        }
        const bool mv = 2 * hf + mi < C.nmt;
        LA[mi] = mv ? (R.av[mi][0] * R.av[mi][1]) * (R.av[mi][2] * R.av[mi][3]) : 1.0f;
        LB[mi] = mv ? ((R.bv[mi][0] * R.av[mi][1] + R.bv[mi][1]) * R.av[mi][2] + R.bv[mi][2]) * R.av[mi][3] + R.bv[mi][3] : 0.0f;
    }
    {
        const int fr = C.fr;
        float A0[2], A1[2], A2[2], A3[2], B0[2], B1[2], B2[2], B3[2];
#pragma unroll
        for (int mi = 0; mi < 2; ++mi) { A0[mi] = __shfl(LA[mi], fr); A1[mi] = __shfl(LA[mi], fr + 16); A2[mi] = __shfl(LA[mi], fr + 32); A3[mi] = __shfl(LA[mi], fr + 48);
            B0[mi] = __shfl(LB[mi], fr); B1[mi] = __shfl(LB[mi], fr + 16); B2[mi] = __shfl(LB[mi], fr + 32); B3[mi] = __shfl(LB[mi], fr + 48); }
#pragma unroll
        for (int mi = 0; mi < 2; ++mi) {
            const float p2a = A1[mi] * A0[mi], p2b = A1[mi] * B0[mi] + B1[mi], p3a = A2[mi] * p2a, p3b = A2[mi] * p2b + B2[mi];
            R.TA[mi] = A3[mi] * p3a; R.TB[mi] = A3[mi] * p3b + B3[mi];
            R.PA[mi] = fq == 0 ? 1.f : (fq == 1 ? A0[mi] : (fq == 2 ? p2a : p3a));
            R.PB[mi] = fq == 0 ? 0.f : (fq == 1 ? B0[mi] : (fq == 2 ? p2b : p3b));
        }
    }
    R.AW = R.TA[0] * R.TA[1]; R.BW = R.TB[0] * R.TA[1] + R.TB[1];
    if (hf == 0 && fq == 0) { *(LAS f32x2*)(C.pcomp) = (f32x2){R.AW, R.BW}; }
}

__device__ __forceinline__ void mixer_s3(const MixC& C, const int ck, const MixS2& R) {
    const int hf = C.hf, fq = C.fq;
    const float hprev = *(const LAS float*)(C.pcarry + (ck & 1) * 256);
    const f32x2 c0 = *(const LAS f32x2*)(C.pcomp);
    asm volatile("s_waitcnt lgkmcnt(0)" ::: "memory");
    const float hst = hf == 0 ? hprev : c0[0] * hprev + c0[1];
    if (hf == 1 && fq == 0) *(LAS float*)(C.pcarry + ((ck + 1) & 1) * 256) = R.AW * hst + R.BW;
#pragma unroll
    for (int mi = 0; mi < 2; ++mi) {
        const float hin = mi == 0 ? hst : R.TA[0] * hst + R.TB[0];
        const float h0 = R.av[mi][0] * (R.PA[mi] * hin + R.PB[mi]) + R.bv[mi][0], h1 = R.av[mi][1] * h0 + R.bv[mi][1], h2 = R.av[mi][2] * h1 + R.bv[mi][2], h3 = R.av[mi][3] * h2 + R.bv[mi][3];
        const f32x2 o01 = (f32x2){h0, h1} * (f32x2){R.fl[mi][0], R.fl[mi][1]} + (f32x2){R.pl[mi][0], R.pl[mi][1]}, o23 = (f32x2){h2, h3} * (f32x2){R.fl[mi][2], R.fl[mi][3]} + (f32x2){R.pl[mi][2], R.pl[mi][3]};
        const unsigned p01 = pg8::cvt_pk_bf16(o01[0], o01[1]), p23 = pg8::cvt_pk_bf16(o23[0], o23[1]);
        if (2 * hf + mi < C.nmt) {
            *(LAS unsigned short*)(C.pout + (16 * mi + 0) * XS) = (unsigned short)p01; *(LAS unsigned short*)(C.pout + (16 * mi + 1) * XS) = (unsigned short)(p01 >> 16);
            *(LAS unsigned short*)(C.pout + (16 * mi + 2) * XS) = (unsigned short)p23; *(LAS unsigned short*)(C.pout + (16 * mi + 3) * XS) = (unsigned short)(p23 >> 16); }
    }
}

__device__ __forceinline__ void mixer_item(LAS unsigned char* lds, const MixP& P, const int it, const int wave_s) {
    const int tid = opaque_tid(wave_s), lane = tid & 63, wave = __builtin_amdgcn_readfirstlane(tid >> 6), fr = lane & 15, fq = lane >> 4;
    const bool prm = it < 256;
    const int b = prm ? (it >> 4) : ((it - 256) >> 4), h = it & 15, g = h >> 2;
    const int T = prm ? SEQ : DS; const int grow0 = prm ? b * SEQ : NP + b * DS; const int pos0 = prm ? 0 : PAST;
    const int nck = (T + 63) >> 6; const int Tc = T < 64 ? T : 64; const int nmt = Tc >> 4;
    const int n = wave & 3, hf = wave >> 2;
    const int c16 = 16 * n + fr;
    const int d = h * 64 + c16;
    const int srow = tid >> 3, spc = tid & 7, xrow = tid >> 4, xpc = tid & 15;
    const int srow_c = srow < Tc ? srow : Tc - 1, xrow_c0 = xrow < Tc ? xrow : Tc - 1, xrow_c1 = (xrow + 32) < Tc ? (xrow + 32) : Tc - 1;
    MixC C;
    { const bf16_t* wa = P.wt_ra + h * 4096 + c16 * 64 + 8 * fq; const bf16_t* wi = P.wt_ri + h * 4096 + c16 * 64 + 8 * fq;
      C.wfa[0] = *(const bf16x8*)(wa); C.wfa[1] = *(const bf16x8*)(wa + 32); C.wfi[0] = *(const bf16x8*)(wi); C.wfi[1] = *(const bf16x8*)(wi + 32);
      const bf16_t* wp = P.wt_pool + g * 32768 + ((h & 3) * 64 + c16) * 128 + 8 * fq;
      C.wfp[0] = *(const bf16x8*)(wp); C.wfp[1] = *(const bf16x8*)(wp + 32); C.wfp[2] = *(const bf16x8*)(wp + 64); C.wfp[3] = *(const bf16x8*)(wp + 96); }
    C.cw0 = P.conv_w[0 * D + d]; C.cw1 = P.conv_w[1 * D + d]; C.cw2 = P.conv_w[2 * D + d]; C.cw3 = P.conv_w[3 * D + d]; C.cb = P.conv_b[d];
    C.ba = -1.44269504088896341f * P.b_rg_a[d]; C.bi = -1.44269504088896341f * P.b_rg_i[d];
    C.c7 = P.lru_lambda[d];
    C.bp = P.b_pool[g * 256 + (h & 3) * 64 + c16] * P.pool_scale[d];
    C.hf = hf; C.fq = fq; C.fr = fr; C.nmt = nmt; C.Tc = Tc; C.wave = wave;
    C.pxl = lds + L_XLR + (32 * hf + 4 * fq) * XS + c16 * 2;
    C.paxw = lds + L_AX + (32 * hf + 4 * fq) * XS + c16 * 2;
    C.paxr = lds + L_AX + (32 * hf + fr) * XS + 16 * fq;
    C.papr = lds + L_AP + (32 * hf + fr) * PS + 16 * fq;
    C.pfl = lds + L_FL + (32 * hf + 4 * fq) * XS + c16 * 2;
    C.pout = lds + L_OUT + (32 * hf + 4 * fq) * XS + c16 * 2;
    C.W = 2 << g;
    { short bw[8];
#pragma unroll
      for (int jj = 0; jj < 8; ++jj) { const int dd = fr + 16 - (8 * fq + jj); const float cf = ((dd >= 0 && dd < C.W) ? 1.0f / (float)C.W : 0.f) - (dd == 0 ? 1.0f : 0.f); bw[jj] = (short)f2bf(cf); }
      C.bandA = (bf16x8){bw[0], bw[1], bw[2], bw[3], bw[4], bw[5], bw[6], bw[7]}; }
    C.ptr = lds + L_XPR + (16 * (wave & 3) + 8 * fq + (fr >> 2)) * PS + (fr & 3) * 8 + (wave >> 2) * 128;
    C.papw = lds + L_AP + (16 * (wave & 3) + 4 * fq) * PS + ((wave >> 2) * 64 + fr) * 2;
    if (tid < 64) *(LAS unsigned*)(lds + L_XPR + tid * 4) = 0u;
    C.pcomp = lds + L_COMP + c16 * 8; C.pcarry = lds + L_CARRY + c16 * 4;
    if (hf == 0 && fq == 0) *(LAS float*)(C.pcarry) = prm ? 0.f : P.state_lru[(size_t)b * D + d];
    if (tid < 192) { const int r = tid >> 6, c = tid & 63; const float v = prm ? 0.f : P.state_conv[((size_t)b * 3 + r) * D + h * 64 + c];
        *(LAS unsigned short*)(lds + L_XLR + (13 + r) * XS + c * 2) = (unsigned short)f2bf(v); }
    for (int e = tid; e < 15 * 128; e += NWAVES * 64) { const int r = e >> 7, c = e & 127; const float v = prm ? 0.f : P.state_pool[((size_t)b * 15 + r) * DPOOL + g * 128 + c];
        *(LAS unsigned short*)(lds + L_XPR + (1 + r) * PS + c * 2) = (unsigned short)f2bf(v); }
    u32x4 hXL, hXP0, hXP1, sFL, sFP;
#define MX_LOADH(tc_) do { const int tc = (tc_) < T ? (tc_) : (nck - 1) * 64; \
        hXL = __builtin_nontemporal_load((const u32x4*)(P.proj + (size_t)M * P_XL + ((size_t)h * M + grow0 + tc + srow_c) * 64 + spc * 8)); \
        const bf16_t* px = P.proj + (size_t)M * P_XP + ((size_t)g * M + grow0 + tc) * 128 + xpc * 8; \
        hXP0 = *(const u32x4*)(px + (size_t)xrow_c0 * 128); hXP1 = *(const u32x4*)(px + (size_t)xrow_c1 * 128); } while (0)
#define MX_LOADF(tc_) do { const int tc = (tc_) < T ? (tc_) : (nck - 1) * 64; const bf16_t* pr = P.proj + ((size_t)h * M + grow0 + tc + srow_c) * 64 + spc * 8; \
        sFL = __builtin_nontemporal_load((const u32x4*)(pr + (size_t)M * P_FL)); sFP = __builtin_nontemporal_load((const u32x4*)(pr + (size_t)M * P_FP)); } while (0)
#define MX_WRITEH(NB) do { *(LAS u32x4*)(lds + L_XLR + ((NB) + srow) * XS + spc * 16) = hXL; \
        *(LAS u32x4*)(lds + L_XPR + ((NB) + xrow) * PS + xpc * 16) = hXP0; *(LAS u32x4*)(lds + L_XPR + ((NB) + xrow + 32) * PS + xpc * 16) = hXP1; \
        if ((NB) == 80) { if (srow >= 48) *(LAS u32x4*)(lds + L_XLR + (srow - 48) * XS + spc * 16) = hXL; \
                          if (xrow >= 16) *(LAS u32x4*)(lds + L_XPR + (xrow - 16) * PS + xpc * 16) = hXP1; } } while (0)
#define MX_WRITEF() do { *(LAS u32x4*)(lds + L_FL + srow * XS + spc * 16) = sFL; *(LAS u32x4*)(lds + L_FP + srow * XS + spc * 16) = sFP; } while (0)
#define MX_STORE(tc) do { if (srow < Tc) { const u32x4 o = *(const LAS u32x4*)(lds + L_OUT + srow * XS + spc * 16); \
        *(u32x4*)(P.merged + (size_t)(grow0 + (tc) + srow) * D + h * 64 + spc * 8) = o; } } while (0)
    MX_LOADH(0); MX_LOADF(0); MX_WRITEH(16); MX_WRITEF();
    MX_LOADH(64);
    MX_BAR();
    float xcA[2][4], xcB[2][4];
    mixer_s1<16, 0>(C, pos0, xcA);
    MX_BAR();
    MX_WRITEH(80);
    MX_BAR();
    MixS2 R;
    for (int ck = 0; ck < nck; ck += 2) {
        const int tch = ck * 64;
        MX_LOADH(tch + 128); MX_LOADF(tch + 64);
        mixer_s2<0>(C, pos0 + tch, xcA, R);
        if (ck + 1 < nck) mixer_s1<80, 1>(C, pos0 + tch + 64, xcB);
        MX_BAR();
        mixer_s3(C, ck, R);
        MX_WRITEH(16); MX_WRITEF();
        MX_BAR();
        MX_STORE(tch);
        if (ck + 1 < nck) {
            MX_LOADH(tch + 192); MX_LOADF(tch + 128);
            mixer_s2<1>(C, pos0 + tch + 64, xcB, R);
            if (ck + 2 < nck) mixer_s1<16, 0>(C, pos0 + tch + 128, xcA);
            MX_BAR();
            mixer_s3(C, ck + 1, R);
            MX_WRITEH(80); MX_WRITEF();
            MX_BAR();
            MX_STORE(tch + 64);
        }
    }
    {
        const int LB = ((nck - 1) & 1) ? 80 : 16;
        if (tid < 192) { const int r = tid >> 6, c = tid & 63;
            P.out[(prm ? O_CONV_P : O_CONV_S) + ((size_t)b * 3 + r) * D + h * 64 + c] = ldbf(lds + L_XLR + (LB + Tc - 3 + r) * XS + c * 2); }
        if ((h & 3) == 0) for (int e = tid; e < 15 * 128; e += NWAVES * 64) { const int r = e >> 7, c = e & 127;
            P.out[(prm ? O_POOL_P : O_POOL_S) + ((size_t)b * 15 + r) * DPOOL + g * 128 + c] = ldbf(lds + L_XPR + (LB + Tc - 15 + r) * PS + c * 2); }
        if (hf == 0 && fq == 0) P.out[(prm ? O_LRU_P : O_LRU_S) + (size_t)b * D + d] = *(const LAS float*)(C.pcarry + (nck & 1) * 256);
    }
    MX_BAR();
#undef MX_LOADH
#undef MX_LOADF
#undef MX_WRITEH
#undef MX_WRITEF
#undef MX_STORE
}
#undef MX_BAR
}

#define XB_TMO      128
#define XB_XCNT(j)  (256  + 64 * (j))
#define XB_XSUB(j)  (1280 + 64 * (j))
#define XB_XGEN(j)  (2304 + 64 * (j))
#define XB_TOP      3328
#define XB_TOPGEN   3392
#define XCD_BAR_WORDS 3456
#define XB_SPIN_CAP (1u << 18)
__device__ __forceinline__ unsigned xb_ld(unsigned* p)              { return __hip_atomic_load(p, __ATOMIC_RELAXED, __HIP_MEMORY_SCOPE_AGENT); }
__device__ __forceinline__ unsigned xb_add(unsigned* p, unsigned v) { return __hip_atomic_fetch_add(p, v, __ATOMIC_RELAXED, __HIP_MEMORY_SCOPE_AGENT); }
__device__ __forceinline__ unsigned xb_xcc_id() { return (unsigned)__builtin_amdgcn_s_getreg((3 << 11) | 20) & 0xFu; }
#define XB_SPIN(cond, bar) do { unsigned _sp = 0; while (cond) { __builtin_amdgcn_s_sleep(1); \
    if ((++_sp & 255u) == 0u) { if (xb_ld(&(bar)[XB_TMO])) break; if (_sp > XB_SPIN_CAP) { atomicAdd(&(bar)[XB_TMO], 1u); break; } } } } while (0)
struct XcdBarrier { unsigned* bar; unsigned x; volatile LAS unsigned* st; };
__device__ __forceinline__ XcdBarrier xcd_barrier_post(unsigned* bar, volatile LAS unsigned* st) {
    XcdBarrier b; b.bar = bar; b.x = xb_xcc_id(); b.st = st;
    if (threadIdx.x == 0) (void)xb_add(&bar[XB_XCNT(b.x)], 1u);
    return b;
}
__device__ __forceinline__ void xcd_barrier_complete(unsigned* bar, unsigned x, unsigned& nloc, unsigned& nx) {
    const unsigned G = gridDim.x * gridDim.y * gridDim.z;
    unsigned sum, cnt, mine, sp = 0u;
    for (;;) {
        sum = 0u; cnt = 0u; mine = 0u;
#pragma unroll
        for (unsigned j = 0; j < 16; ++j) { const unsigned c = xb_ld(&bar[XB_XCNT(j)]); sum += c; cnt += (c > 0u) ? 1u : 0u; mine = (j == x) ? c : mine; }
        if (sum == G) break;
        __builtin_amdgcn_s_sleep(1);
        if ((++sp & 255u) == 0u) { if (xb_ld(&bar[XB_TMO])) break; if (sp > XB_SPIN_CAP) { atomicAdd(&bar[XB_TMO], 1u); break; } }
    }
    nloc = mine > 0u ? mine : 1u; nx = cnt > 0u ? cnt : 1u;
}
__device__ __forceinline__ void xcd_barrier(const XcdBarrier& b, const int wave_s) {
    asm volatile("s_waitcnt vmcnt(0)" ::: "memory");
    __syncthreads();
    int bl_; asm volatile("v_mbcnt_lo_u32_b32 %0, -1, 0\n\tv_mbcnt_hi_u32_b32 %0, -1, %0" : "=v"(bl_));
    if (wave_s == 0 && bl_ == 0) {
        unsigned* bar = b.bar;
        __builtin_amdgcn_s_waitcnt(0);
        unsigned nloc = b.st[0], nx = b.st[1];
        if (nloc == 0u) { xcd_barrier_complete(bar, b.x, nloc, nx); b.st[0] = nloc; b.st[1] = nx; }
        const unsigned old = xb_add(&bar[XB_XSUB(b.x)], 1u);
        const unsigned gen = old / nloc;
        if (old + 1u == (gen + 1u) * nloc) {
            __builtin_amdgcn_fence(__ATOMIC_RELEASE, "agent");
            asm volatile("s_waitcnt vmcnt(0)" ::: "memory");
            const unsigned og = xb_add(&bar[XB_TOP], 1u);
            const unsigned tg = og / nx;
            if (og + 1u == (tg + 1u) * nx) xb_add(&bar[XB_TOPGEN], 1u);
            else XB_SPIN(xb_ld(&bar[XB_TOPGEN]) == tg, bar);
            __builtin_amdgcn_fence(__ATOMIC_ACQUIRE, "agent");
            xb_add(&bar[XB_XGEN(b.x)], 1u);
            asm volatile("s_waitcnt vmcnt(0)" ::: "memory");
        } else {
            XB_SPIN(xb_ld(&bar[XB_XGEN(b.x)]) == gen, bar);
            __builtin_amdgcn_fence(__ATOMIC_ACQUIRE, "agent");
            asm volatile("s_waitcnt vmcnt(0)" ::: "memory");
        }
    }
    __syncthreads();
}
constexpr int MISC_OFF = LDS_BYTES - 256;
constexpr int CW_BAR = 4096;

struct Args { const float* in[24]; float* out; unsigned char* ws; int ph_lo, ph_hi; };

__device__ __forceinline__ void p0_transpose_item(const float* W, int K, int N, bf16_t* WT, const float* kscale, LAS float* scr, int item, int lane, bool map_in = false, float cscale = 1.0f, const float* nscale = nullptr) {
    const int nblk = N / 32, kb = item / nblk, nb = item % nblk, k0 = 64 * kb, n0 = 32 * nb;
    int d0 = n0;
    if (map_in) {
        if (n0 < C_GL) d0 = P_XL + n0;
        else if (n0 < C_XP) { const int c = n0 - C_GL; d0 = P_FL + (c >> 7) * 256 + (c & 127); }
        else if (n0 < C_GP) d0 = P_XP + (n0 - C_XP);
        else if (n0 < C_ML) { const int c = n0 - C_GP; d0 = P_FL + 2048 + (c >> 7) * 256 + (c & 127); }
        else if (n0 < C_MP) { const int c = n0 - C_ML; d0 = P_FL + (c >> 7) * 256 + 128 + (c & 127); cscale = -1.44269504088896341f; }
        else { const int c = n0 - C_MP; d0 = P_FL + 2048 + (c >> 7) * 256 + 128 + (c & 127); cscale = -1.44269504088896341f; }
    }
    const float ns = (nscale ? nscale[n0 + (lane & 31)] : 1.0f) * cscale;
#pragma unroll 8
    for (int i = 0; i < 32; ++i) { const int kk = 2 * i + (lane >> 5); const float sc = (kscale ? kscale[k0 + kk] : 1.0f) * ns; scr[kk * 33 + (lane & 31)] = W[(size_t)(k0 + kk) * N + n0 + (lane & 31)] * sc; }
    LDS_WAIT(); asm volatile("" ::: "memory");
    const int c = lane & 7;
#pragma unroll
    for (int j = 0; j < 4; ++j) { const int n = (lane >> 3) + 8 * j; const LAS float* s = scr + (8 * c) * 33 + n;
        u32x4 o; o.x = pk2(s[0 * 33], s[1 * 33]); o.y = pk2(s[2 * 33], s[3 * 33]); o.z = pk2(s[4 * 33], s[5 * 33]); o.w = pk2(s[6 * 33], s[7 * 33]);
        *(u32x4*)(WT + (size_t)(d0 + n) * K + k0 + 8 * c) = o; }
    LDS_WAIT(); asm volatile("" ::: "memory");
}

__global__ void __launch_bounds__(NWAVES * 64, 2) fwd(Args args) {
    extern __shared__ __attribute__((aligned(16))) unsigned char lds_raw[];
    LAS unsigned char* lds = (LAS unsigned char*)lds_raw;
    const int G = gridDim.x, bid = blockIdx.x;
    const int NGW = G * NWAVES;
    unsigned char* ws = args.ws;
    const float* x_prompt = args.in[0]; const float* x_sample = args.in[1]; const float* p_prompt = args.in[2]; const float* p_sample = args.in[3];
    const float* state_conv = args.in[4]; const float* state_lru = args.in[5]; const float* state_pool = args.in[6];
    const float* norm_mix = args.in[7]; const float* w_in = args.in[8]; const float* conv_w = args.in[9]; const float* conv_b = args.in[10];
    const float* w_rg_a = args.in[11]; const float* b_rg_a = args.in[12]; const float* w_rg_i = args.in[13]; const float* b_rg_i = args.in[14];
    const float* lru_lambda = args.in[15]; const float* w_pool = args.in[16]; const float* b_pool = args.in[17]; const float* pool_scale = args.in[18];
    const float* w_out = args.in[19]; const float* norm_ple = args.in[20]; const float* w_ple_gate = args.in[21]; const float* w_ple = args.in[22]; const float* final_norm = args.in[23];
    float* out = args.out;
    bf16_t* Wt_in = (bf16_t*)(ws + WS_WIN); bf16_t* Wt_out = (bf16_t*)(ws + WS_WOUT); bf16_t* Wt_pg = (bf16_t*)(ws + WS_WPG); bf16_t* Wt_pe = (bf16_t*)(ws + WS_WPE);
    bf16_t* PB = (bf16_t*)(ws + WS_PB); bf16_t* U = (bf16_t*)(ws + WS_U); bf16_t* MERGED = (bf16_t*)(ws + WS_MERGED);
    float* SS2 = (float*)(ws + WS_SS2); float* RS = (float*)(ws + WS_RS);
    bf16_t* PROJ = (bf16_t*)(ws + WS_PROJ); bf16_t* X2B = (bf16_t*)(ws + WS_X2B); bf16_t* PE = (bf16_t*)(ws + WS_PE); bf16_t* GPRE = (bf16_t*)(ws + WS_GPRE);
    const int lo = args.ph_lo, hi = args.ph_hi;
    const int wave_s = __builtin_amdgcn_readfirstlane(threadIdx.x >> 6);
    if (threadIdx.x < 64) ((LAS unsigned*)(lds + MISC_OFF))[threadIdx.x] = 0u;
    __syncthreads();
    const XcdBarrier xbar = xcd_barrier_post((unsigned*)(ws + WS_CTL) + CW_BAR, (volatile LAS unsigned*)(lds + MISC_OFF) + 8);
#define IN(k) (lo <= (k) && (k) < hi)
#define BOTH(k) (IN(k) && IN((k) + 1))
#define GRID_BAR() do { xcd_barrier(xbar, wave_s); } while (0)

    if (IN(0)) {
      const int tid = opaque_tid(wave_s), lane = tid & 63, wave = wave_s, gw = bid * NWAVES + wave;
      for (int rep = 0; rep < REP_P0; ++rep) {
        LAS float* scr = (LAS float*)(lds + wave * 16384);
        constexpr int I_IN = (D / 64) * (INC / 32), I_SQ = (D / 64) * (D / 32), I_PE = (DPLE / 64) * (D / 32);
        constexpr int I_RG = 16 * 2, I_PL = 4 * 16;
        constexpr int NITEMS = I_IN + 2 * I_SQ + I_PE + 2 * I_RG + I_PL;
        for (int it = gw; it < NITEMS; it += NGW) {
            int r = it;
            if (r >= I_IN + 2 * I_SQ + I_PE) { r -= I_IN + 2 * I_SQ + I_PE;
                if (r < I_RG) { p0_transpose_item(w_rg_a + (r >> 1) * 4096, 64, 64, (bf16_t*)(ws + WS_WRA) + (r >> 1) * 4096, nullptr, scr, r & 1, lane, false, -1.44269504088896341f); continue; } r -= I_RG;
                if (r < I_RG) { p0_transpose_item(w_rg_i + (r >> 1) * 4096, 64, 64, (bf16_t*)(ws + WS_WRI) + (r >> 1) * 4096, nullptr, scr, r & 1, lane, false, -1.44269504088896341f); continue; } r -= I_RG;
                p0_transpose_item(w_pool + (r >> 4) * 32768, 128, 256, (bf16_t*)(ws + WS_WPOOL) + (r >> 4) * 32768, nullptr, scr, r & 15, lane, false, 1.0f, pool_scale + (r >> 4) * 256); continue; }
            if (r < I_IN) { p0_transpose_item(w_in, D, INC, Wt_in, norm_mix, scr, r, lane, true); continue; } r -= I_IN;
            if (r < I_SQ) { p0_transpose_item(w_out, D, D, Wt_out, nullptr, scr, r, lane); continue; } r -= I_SQ;
            if (r < I_SQ) { p0_transpose_item(w_ple_gate, D, D, Wt_pg, norm_ple, scr, r, lane); continue; } r -= I_SQ;
            p0_transpose_item(w_ple, DPLE, D, Wt_pe, nullptr, scr, r, lane);
        }
        if (gw < 16) { const int d = gw * 64 + lane; const float nl = -lru_lambda[d]; ((float*)(ws + WS_C7))[d] = -8.0f * 1.44269504088896341f * (fmaxf(nl, 0.f) + log1pf(expf(-fabsf(nl)))); }
        for (int m = gw; m < M; m += NGW) {
            const float* xrow = (m < NP) ? x_prompt + (size_t)m * D : x_sample + (size_t)(m - NP) * D;
            const f32x4* xr = (const f32x4*)xrow + lane;
            f32x4 v[4]; float s = 0.f;
#pragma unroll
            for (int j = 0; j < 4; ++j) { v[j] = __builtin_nontemporal_load(xr + 64 * j); s += (v[j][0] * v[j][0] + v[j][1] * v[j][1]) + (v[j][2] * v[j][2] + v[j][3] * v[j][3]); }
            const float ms = wave_sum(s) * (1.0f / D) + EPS; const float rstd = __builtin_amdgcn_rsqf(ms);
            if (lane == 0) RS[m] = ms * rstd;
            u32x2* o8 = (u32x2*)(U + (size_t)m * D) + lane;
#pragma unroll
            for (int j = 0; j < 4; ++j) { u32x2 w; w.x = pk2(v[j][0] * rstd, v[j][1] * rstd); w.y = pk2(v[j][2] * rstd, v[j][3] * rstd); o8[64 * j] = w; }
        }
        {
            const size_t nvec = (size_t)M * DPLE / 8, npv = (size_t)NP * DPLE / 8;
            for (size_t i = (size_t)bid * (NWAVES * 64) + tid; i < nvec; i += (size_t)G * NWAVES * 64) {
                const f32x4* src = (i < npv) ? (const f32x4*)p_prompt + 2 * i : (const f32x4*)p_sample + 2 * (i - npv);
                const f32x4 a = __builtin_nontemporal_load(src), b = __builtin_nontemporal_load(src + 1);
                u32x4 w; w.x = pk2(a[0], a[1]); w.y = pk2(a[2], a[3]); w.z = pk2(b[0], b[1]); w.w = pk2(b[2], b[3]);
                ((u32x4*)PB)[i] = w;
            }
        }
      }
        if (BOTH(0)) GRID_BAR();
    }

    if (IN(1)) {
        pg8::Gemm g{U, Wt_in, M, INC, D}; pg8::StaticOrder S; S.init(M, INC, G, bid);
        pg8::EpiProj E{PROJ};
        for (int rep = 0; rep < REP_P1; ++rep) pg8::gemm_phase<pg8::EpiProj, pg8::StaticOrder, true, true>(lds, g, S, E, wave_s);
        if (BOTH(1)) GRID_BAR();
    }

    if (IN(2)) {
        mx::MixP P{PROJ, MERGED, out, state_conv, state_lru, state_pool, conv_w, conv_b, b_rg_a, b_rg_i, (const float*)(ws + WS_C7), b_pool, pool_scale,
                   (const bf16_t*)(ws + WS_WRA), (const bf16_t*)(ws + WS_WRI), (const bf16_t*)(ws + WS_WPOOL)};
#ifndef SAMPLE_REP
#define SAMPLE_REP 1
#endif
        for (int ii = 0; ii < 1 + 2 * SAMPLE_REP; ++ii) mx::mixer_item(lds, P, ii == 0 ? bid : 256 + 2 * bid + ((ii - 1) & 1), wave_s);
        if (BOTH(2)) GRID_BAR();
    }

    if (IN(3)) {
        { pg8::Gemm g{MERGED, Wt_out, M, D, D}; pg8::PanelTail S{bid};
          pg8::EpiRes1 E{U, RS, X2B, SS2};
          pg8::gemm_phase<pg8::EpiRes1, pg8::PanelTail, true, true, true>(lds, g, S, E, wave_s); }
        { pg8::Gemm g{PB, Wt_pe, M, D, DPLE}; pg8::PeA S{bid};
          pg8::EpiBf16 E{PE, D};
          pg8::gemm_phase<pg8::EpiBf16, pg8::PeA, true, true, true>(lds, g, S, E, wave_s); }
        if (BOTH(3)) GRID_BAR();
    }

    if (IN(4)) {
        pg8::Gemm g{X2B, Wt_pg, M, D, D}; pg8::PanelTail S{bid};
        pg8::EpiBf16 E{GPRE, D};
        pg8::gemm_phase<pg8::EpiBf16, pg8::PanelTail, true, true, true>(lds, g, S, E, wave_s);
        { pg8::Gemm g2{PB, Wt_pe, M, D, DPLE}; pg8::PeB S2{bid};
          pg8::EpiBf16 E2{PE, D};
          pg8::gemm_phase<pg8::EpiBf16, pg8::PeB, true, true, true>(lds, g2, S2, E2, wave_s); }
        if (BOTH(4)) GRID_BAR();
    }

    if (IN(5)) {
        const int tid = opaque_tid(wave_s), lane = tid & 63, wave = wave_s, gw = bid * NWAVES + wave;
        f32x4 gsc[4];
#pragma unroll
        for (int j = 0; j < 2; ++j) { gsc[2 * j] = *(const f32x4*)(final_norm + 512 * j + 8 * lane); gsc[2 * j + 1] = *(const f32x4*)(final_norm + 512 * j + 8 * lane + 4); }
        u32x4 xq[2], gq[2], pq[2]; float pv;
#define P5_LOAD(m_) do { const size_t ro = (size_t)(m_) * D + 8 * lane; \
            xq[0] = __builtin_nontemporal_load((const u32x4*)(X2B + ro)); xq[1] = __builtin_nontemporal_load((const u32x4*)(X2B + ro + 512)); gq[0] = __builtin_nontemporal_load((const u32x4*)(GPRE + ro)); gq[1] = __builtin_nontemporal_load((const u32x4*)(GPRE + ro + 512)); \
            pq[0] = __builtin_nontemporal_load((const u32x4*)(PE + ro)); pq[1] = __builtin_nontemporal_load((const u32x4*)(PE + ro + 512)); pv = SS2[(size_t)(m_) * 16 + (lane & 15)]; } while (0)
        int m = gw;
        if (m < M) P5_LOAD(m);
        while (m < M) {
            u32x4 cx[2], cg[2], cp[2]; cx[0] = xq[0]; cx[1] = xq[1]; cg[0] = gq[0]; cg[1] = gq[1]; cp[0] = pq[0]; cp[1] = pq[1]; const float cpv = pv;
            const int mn = m + NGW;
            if (mn < M) P5_LOAD(mn);
            float t16 = cpv; t16 += dpp_mov<0xB1>(t16); t16 += dpp_mov<0x4E>(t16); t16 += dpp_mov<0x141>(t16); t16 += dpp_mov<0x140>(t16);
            const float rstd2 = __builtin_amdgcn_rsqf(t16 * (1.0f / D) + EPS);
            float v[16]; float s = 0.f;
#pragma unroll
            for (int j = 0; j < 2; ++j)
#pragma unroll
                for (int q = 0; q < 4; ++q) {
                    const unsigned xw = cx[j][q], gw2 = cg[j][q], pw = cp[j][q];
                    const float x0 = __uint_as_float(xw << 16), x1 = __uint_as_float(xw & 0xffff0000u);
                    const float g0 = __uint_as_float(gw2 << 16) * rstd2, g1 = __uint_as_float(gw2 & 0xffff0000u) * rstd2;
                    const float p0 = __uint_as_float(pw << 16), p1 = __uint_as_float(pw & 0xffff0000u);
                    const float y0 = x0 + p0 * sigm(g0), y1 = x1 + p1 * sigm(g1);
                    v[8 * j + 2 * q] = y0; v[8 * j + 2 * q + 1] = y1; s += y0 * y0 + y1 * y1;
                }
            const float rstd3 = __builtin_amdgcn_rsqf(wave_sum(s) * (1.0f / D) + EPS);
            float* yr = out + O_Y + (size_t)m * D + 8 * lane;
#pragma unroll
            for (int j = 0; j < 2; ++j) {
                f32x4 o0, o1;
#pragma unroll
                for (int q = 0; q < 4; ++q) { o0[q] = v[8 * j + q] * rstd3 * gsc[2 * j][q]; o1[q] = v[8 * j + 4 + q] * rstd3 * gsc[2 * j + 1][q]; }
                __builtin_nontemporal_store(o0, (f32x4*)(yr + 512 * j)); __builtin_nontemporal_store(o1, (f32x4*)(yr + 512 * j + 4));
            }
            m = mn;
        }
#undef P5_LOAD
    }
#undef IN
#undef BOTH
#undef GRID_BAR
}

extern "C" void kernel_launch(void* const* d_in, const int* in_sizes, int n_in, void* d_out, int out_size, void* d_ws, size_t ws_size, hipStream_t stream) {
    static int grid = 0;
    if (grid == 0) {
        if (n_in != 24 || (size_t)out_size != O_END || ws_size < WS_END) { fprintf(stderr, "kernel_launch: unexpected shapes: n_in %d out %d ws %zu\n", n_in, out_size, ws_size); grid = -1; return; }
        if (hipFuncSetAttribute((const void*)fwd, hipFuncAttributeMaxDynamicSharedMemorySize, LDS_BYTES) != hipSuccess) { fprintf(stderr, "kernel_launch: hipFuncSetAttribute failed\n"); grid = -1; return; }
        int dev = 0, cus = 0, per_cu = 0;
        (void)hipGetDevice(&dev); (void)hipDeviceGetAttribute(&cus, hipDeviceAttributeMultiprocessorCount, dev);
        (void)hipOccupancyMaxActiveBlocksPerMultiprocessor(&per_cu, (const void*)fwd, NWAVES * 64, LDS_BYTES);
        (void)hipGetLastError();
        if (cus != 256 || per_cu < 1) { fprintf(stderr, "kernel_launch: built for 256 CUs x 1 block; got %d CUs, %d blocks/CU\n", cus, per_cu); grid = -1; return; }
        grid = 256;
    }
    if (grid < 0) return;
    Args a{};
    for (int i = 0; i < 24; ++i) a.in[i] = (const float*)d_in[i];
    a.out = (float*)d_out; a.ws = (unsigned char*)d_ws;
#ifndef PHASE_SEQ
#define PHASE_SEQ {{0, 6}}
#endif
    static const int seq[][2] = PHASE_SEQ;
    hipError_t e = hipSuccess;
    for (unsigned li = 0; li < sizeof(seq) / sizeof(seq[0]); ++li) {
        if (hipMemsetAsync((char*)d_ws + WS_CTL, 0, CTL_ZERO_BYTES, stream) != hipSuccess) { fprintf(stderr, "kernel_launch: hipMemsetAsync failed\n"); return; }
        a.ph_lo = seq[li][0]; a.ph_hi = seq[li][1];
        hipLaunchKernelGGL(fwd, dim3(grid), dim3(NWAVES * 64), LDS_BYTES, stream, a);
        e = hipPeekAtLastError(); if (e != hipSuccess) break;
    }
    if (e != hipSuccess) fprintf(stderr, "kernel_launch: launch failed: %s\n", hipGetErrorString(e));
}
```

```cpp
#include <hip/hip_runtime.h>
#include <hip/hip_cooperative_groups.h>
#include <cstdio>
#include <cstdint>
namespace cg = cooperative_groups;

#define LAS __attribute__((address_space(3)))
typedef unsigned short bf16_t;
typedef short bf16x8 __attribute__((ext_vector_type(8)));
typedef float f32x4 __attribute__((ext_vector_type(4)));
typedef float f32x2 __attribute__((ext_vector_type(2)));
typedef unsigned u32x4 __attribute__((ext_vector_type(4)));
typedef unsigned u32x2 __attribute__((ext_vector_type(2)));

constexpr int D = 1024, SEQ = 2048, NB = 16, DB = 32, DS = 32;
constexpr int NP = NB * SEQ;
constexpr int NS = DB * DS;
constexpr int M = NP + NS;
constexpr int INC = 5632, DPLE = 256, DPOOL = 512;
constexpr int C_XL = 0, C_GL = 1024, C_XP = 2048, C_GP = 2560, C_ML = 3584, C_MP = 4608;
constexpr int PC = 3584, P_XL = 0, P_XP = 1024, P_FL = 1536, P_FP = 2560;
constexpr float EPS = 1e-6f;
constexpr int PAST = 2048;

constexpr size_t MiB = 1u << 20;
constexpr size_t WS_CTL = 0, CTL_ZERO_BYTES = 32 * 1024;
constexpr size_t WS_WIN = 1 * MiB;
constexpr size_t WS_WOUT = 12 * MiB;
constexpr size_t WS_WPG = 14 * MiB;
constexpr size_t WS_WPE = 16 * MiB;
constexpr size_t WS_WRA = 16 * MiB + 512 * 1024;
constexpr size_t WS_WRI = WS_WRA + 128 * 1024;
constexpr size_t WS_WPOOL = WS_WRI + 128 * 1024;
constexpr size_t WS_PB = 17 * MiB;
constexpr size_t WS_U = 34 * MiB;
constexpr size_t WS_MERGED = 340 * MiB;
constexpr size_t WS_C7 = 104 * MiB;
constexpr size_t WS_RS = 103 * MiB;
constexpr size_t WS_SS2 = 100 * MiB;
constexpr size_t WS_SS3 = 103 * MiB;
constexpr size_t WS_PROJ = 106 * MiB;
constexpr size_t WS_X2B = WS_PROJ;
constexpr size_t WS_PE = WS_PROJ + 66 * MiB;
constexpr size_t WS_GPRE = WS_PROJ + 132 * MiB;
constexpr size_t WS_END = 469 * MiB;
static_assert(WS_PROJ + (size_t)M * PC * 2 <= WS_END, "ws map");

constexpr size_t O_Y = 0;
constexpr size_t O_CONV_P = (size_t)M * D;
constexpr size_t O_LRU_P = O_CONV_P + (size_t)NB * 3 * D;
constexpr size_t O_POOL_P = O_LRU_P + (size_t)NB * D;
constexpr size_t O_CONV_S = O_POOL_P + (size_t)NB * 15 * DPOOL;
constexpr size_t O_LRU_S = O_CONV_S + (size_t)DB * 3 * D;
constexpr size_t O_POOL_S = O_LRU_S + (size_t)DB * D;
constexpr size_t O_END = O_POOL_S + (size_t)DB * 15 * DPOOL;

#ifndef REP_P0
#define REP_P0 1
#endif
#ifndef REP_P1
#define REP_P1 1
#endif
#ifndef REP_P2
#define REP_P2 1
#endif
#ifndef REP_P3
#define REP_P3 1
#endif
constexpr int NWAVES = 8;
constexpr int LDS_BYTES = 147456;

namespace pg8 {
constexpr int BM = 256, BK = 64, HALF = 128, HTB = HALF * BK * 2, STAGE_BYTES = 8 * HTB, NXCD = 8, WGM = 8;
__host__ __device__ __forceinline__ int lds_byte(int r, int c) { const int st = (r >> 4) * 2 + (c >> 5), rr = r & 15, cc = c & 31, ob = rr * 64 + cc * 2; return st * 1024 + (ob ^ (((ob >> 9) & 1) << 5)); }
__host__ __device__ __forceinline__ void stage_rc(int b, int& R, int& C) { const int st = b / 1024, sb = b % 1024, swz = sb ^ (((sb >> 9) & 1) << 5); R = (st >> 1) * 16 + swz / 64; C = (st & 1) * 32 + (swz % 64) / 2; }
__host__ __device__ __forceinline__ int perm32(int rho) { const int n = rho >> 4, i = rho & 15; return 8 * (i >> 2) + 4 * n + (i & 3); }

struct Unit { int pm, pn, hoff, half; };
struct Gemm { const bf16_t* A; const bf16_t* Bt; int M, N, K; };

struct StaticOrder {
    int nM, nN, nwg, G, c;
    __host__ __device__ void init(int M_, int N_, int G_, int c_) { nM = M_ / BM; nN = N_ / BM; nwg = nM * nN; G = G_; c = c_; }
    __host__ __device__ bool next(int i, Unit& u) const {
        const long L = (long)i * G + c; if (L >= nwg) return false;
        int wgid = (int)L; { const int q = nwg / NXCD, r = nwg % NXCD, xcd = wgid % NXCD, off = wgid / NXCD; wgid = (xcd < r ? xcd * (q + 1) : r * (q + 1) + (xcd - r) * q) + off; }
        const int nig = WGM * nN, gid = wgid / nig, fm = gid * WGM, gsz = (nM - fm) < WGM ? (nM - fm) : WGM;
        u.pm = fm + ((wgid % nig) % gsz); u.pn = (wgid % nig) / gsz; u.hoff = 0; u.half = 0; return true;
    }
    __device__ __forceinline__ void a_ready(const Unit&) const {}
    __device__ __forceinline__ void done(const Unit&) const {}
};

typedef __bf16 bf16x2_n __attribute__((ext_vector_type(2)));
__device__ __forceinline__ unsigned cvt_pk_bf16(float lo, float hi) { const f32x2 v = {lo, hi}; return __builtin_bit_cast(unsigned, __builtin_convertvector(v, bf16x2_n)); }

struct EpiBf16 {
    static constexpr bool PERM = true, AFTER_DRAIN = false;
    bf16_t* O; int ldc;
    template <bool HM> __device__ __forceinline__ void init(f32x4 (&acc)[2][2][4][2], const Unit&, int, int, int, int) const {
#pragma unroll
        for (int a = 0; a < 2; ++a)
#pragma unroll
            for (int b = 0; b < 2; ++b)
#pragma unroll
                for (int m = 0; m < 4; ++m)
#pragma unroll
                    for (int n = 0; n < 2; ++n) acc[a][b][m][n] = (f32x4){0.f, 0.f, 0.f, 0.f};
    }
    template <bool HM> __device__ __forceinline__ void store(const f32x4 (&acc)[2][2][4][2], const Unit& u, int wr, int wc, int fr, int fq) const {
        const int row0 = u.pm * BM + u.hoff + wr * 64 + fr; const int col0 = u.pn * BM + wc * 32 + 8 * fq;
#pragma unroll
        for (int ai = 0; ai < 2; ++ai) if (!(HM && ai == 1 && u.half))
#pragma unroll
            for (int m = 0; m < 4; ++m) { bf16_t* rowp = O + (size_t)(row0 + ai * HALF + m * 16) * ldc + col0;
#pragma unroll
                for (int bj = 0; bj < 2; ++bj) { const f32x4 v0 = acc[ai][bj][m][0], v1 = acc[ai][bj][m][1];
                    u32x4 w; w.x = cvt_pk_bf16(v0[0], v0[1]); w.y = cvt_pk_bf16(v0[2], v0[3]); w.z = cvt_pk_bf16(v1[0], v1[1]); w.w = cvt_pk_bf16(v1[2], v1[3]);
                    *(u32x4*)(rowp + bj * HALF) = w; } }
    }
};
struct EpiProj {
    static constexpr bool PERM = true, AFTER_DRAIN = false;
    bf16_t* O;
    template <bool HM> __device__ __forceinline__ void init(f32x4 (&acc)[2][2][4][2], const Unit&, int, int, int, int) const {
#pragma unroll
        for (int a = 0; a < 2; ++a)
#pragma unroll
            for (int b = 0; b < 2; ++b)
#pragma unroll
                for (int m = 0; m < 4; ++m)
#pragma unroll
                    for (int n = 0; n < 2; ++n) acc[a][b][m][n] = (f32x4){0.f, 0.f, 0.f, 0.f};
    }
    static __device__ __forceinline__ unsigned gate2pk(float ga, float gb, float ma, float mb) {
        const f32x2 g = (f32x2){ga, gb}; const f32x2 t = g * -1.44269504088896341f;
        const f32x2 dg = (f32x2){__builtin_amdgcn_exp2f(t[0]), __builtin_amdgcn_exp2f(t[1])} + 1.0f, dm = (f32x2){__builtin_amdgcn_exp2f(ma), __builtin_amdgcn_exp2f(mb)} + 1.0f;
        const f32x2 den = dg * dm; const f32x2 f = g * (f32x2){__builtin_amdgcn_rcpf(den[0]), __builtin_amdgcn_rcpf(den[1])};
        return cvt_pk_bf16(f[0], f[1]);
    }
    template <bool HM> __device__ __forceinline__ void store(const f32x4 (&acc)[2][2][4][2], const Unit& u, int wr, int wc, int fr, int fq) const {
        const int row0 = u.pm * BM + u.hoff + wr * 64 + fr;
        if (u.pn < 4) {
            bf16_t* base = O + (size_t)M * P_XL + ((size_t)(4 * u.pn + (wc >> 1)) * M + row0) * 64 + 32 * (wc & 1) + 8 * fq;
#pragma unroll
            for (int ai = 0; ai < 2; ++ai) if (!(HM && ai == 1 && u.half))
#pragma unroll
                for (int m = 0; m < 4; ++m)
#pragma unroll
                    for (int bj = 0; bj < 2; ++bj) { const f32x4 v0 = acc[ai][bj][m][0], v1 = acc[ai][bj][m][1];
                        u32x4 w; w.x = cvt_pk_bf16(v0[0], v0[1]); w.y = cvt_pk_bf16(v0[2], v0[3]); w.z = cvt_pk_bf16(v1[0], v1[1]); w.w = cvt_pk_bf16(v1[2], v1[3]);
                        __builtin_nontemporal_store(w, (u32x4*)(base + ((size_t)(2 * bj) * M + ai * HALF + m * 16) * 64)); }
        } else if (u.pn < 6) {
            bf16_t* base = O + (size_t)M * P_XP + ((size_t)(2 * (u.pn - 4)) * M + row0) * 128 + 32 * wc + 8 * fq;
#pragma unroll
            for (int ai = 0; ai < 2; ++ai) if (!(HM && ai == 1 && u.half))
#pragma unroll
                for (int m = 0; m < 4; ++m)
#pragma unroll
                    for (int bj = 0; bj < 2; ++bj) { const f32x4 v0 = acc[ai][bj][m][0], v1 = acc[ai][bj][m][1];
                        u32x4 w; w.x = cvt_pk_bf16(v0[0], v0[1]); w.y = cvt_pk_bf16(v0[2], v0[3]); w.z = cvt_pk_bf16(v1[0], v1[1]); w.w = cvt_pk_bf16(v1[2], v1[3]);
                        __builtin_nontemporal_store(w, (u32x4*)(base + ((size_t)bj * M + ai * HALF + m * 16) * 128)); }
        } else {
            const int q = u.pn - 6;
            bf16_t* base = O + (size_t)M * (P_FL + (q >> 3) * 1024) + ((size_t)(2 * (q & 7) + (wc >> 1)) * M + row0) * 64 + 32 * (wc & 1) + 8 * fq;
#pragma unroll
            for (int ai = 0; ai < 2; ++ai) if (!(HM && ai == 1 && u.half))
#pragma unroll
                for (int m = 0; m < 4; ++m) {
                    const f32x4 g0 = acc[ai][0][m][0], g1 = acc[ai][0][m][1], m0 = acc[ai][1][m][0], m1 = acc[ai][1][m][1];
                    u32x4 w; w.x = gate2pk(g0[0], g0[1], m0[0], m0[1]); w.y = gate2pk(g0[2], g0[3], m0[2], m0[3]);
                    w.z = gate2pk(g1[0], g1[1], m1[0], m1[1]); w.w = gate2pk(g1[2], g1[3], m1[2], m1[3]);
                    __builtin_nontemporal_store(w, (u32x4*)(base + (size_t)(ai * HALF + m * 16) * 64)); }
        }
    }
};
struct EpiRes1 {
    static constexpr bool PERM = true, AFTER_DRAIN = false;
    const bf16_t* U; const float* rs; bf16_t* x2b; float* ss;
    template <bool HM> __device__ __forceinline__ void init(f32x4 (&acc)[2][2][4][2], const Unit& u, int wr, int wc, int fr, int fq) const {
        const bf16_t* ub = U + (size_t)(u.pm * BM + u.hoff) * D + u.pn * BM;
        const unsigned loff = (unsigned)((wr * 64 + fr) * D + wc * 32 + 8 * fq);
        const float* rsb = rs + u.pm * BM + u.hoff + wr * 64 + fr;
        if (HM && u.half) {
#pragma unroll
            for (int b = 0; b < 2; ++b)
#pragma unroll
                for (int m = 0; m < 4; ++m)
#pragma unroll
                    for (int n = 0; n < 2; ++n) acc[1][b][m][n] = (f32x4){0.f, 0.f, 0.f, 0.f};
        }
#pragma unroll
        for (int ai = 0; ai < 2; ++ai) if (!(HM && ai == 1 && u.half))
#pragma unroll
            for (int m = 0; m < 4; ++m) { const bf16_t* rb = ub + (ai * HALF + m * 16) * D; const float r = rsb[ai * HALF + m * 16];
#pragma unroll
                for (int bj = 0; bj < 2; ++bj) { const u32x4 w = __builtin_nontemporal_load((const u32x4*)(rb + loff + bj * HALF));
                    acc[ai][bj][m][0] = (f32x4){__uint_as_float(w.x << 16) * r, __uint_as_float(w.x & 0xffff0000u) * r, __uint_as_float(w.y << 16) * r, __uint_as_float(w.y & 0xffff0000u) * r};
                    acc[ai][bj][m][1] = (f32x4){__uint_as_float(w.z << 16) * r, __uint_as_float(w.z & 0xffff0000u) * r, __uint_as_float(w.w << 16) * r, __uint_as_float(w.w & 0xffff0000u) * r}; } }
    }
    template <bool HM> __device__ __forceinline__ void store(const f32x4 (&acc)[2][2][4][2], const Unit& u, int wr, int wc, int fr, int fq) const {
        const int row0 = u.pm * BM + u.hoff + wr * 64 + fr, col0 = u.pn * BM + wc * 32 + 8 * fq;
#pragma unroll
        for (int ai = 0; ai < 2; ++ai) if (!(HM && ai == 1 && u.half))
#pragma unroll
            for (int m = 0; m < 4; ++m) { const int row = row0 + ai * HALF + m * 16; const size_t off = (size_t)row * D + col0; float s = 0.f;
#pragma unroll
                for (int bj = 0; bj < 2; ++bj) { const f32x4 v0 = acc[ai][bj][m][0], v1 = acc[ai][bj][m][1];
                    s += ((v0[0] * v0[0] + v0[1] * v0[1]) + (v0[2] * v0[2] + v0[3] * v0[3])) + ((v1[0] * v1[0] + v1[1] * v1[1]) + (v1[2] * v1[2] + v1[3] * v1[3]));
                    u32x4 w; w.x = cvt_pk_bf16(v0[0], v0[1]); w.y = cvt_pk_bf16(v0[2], v0[3]); w.z = cvt_pk_bf16(v1[0], v1[1]); w.w = cvt_pk_bf16(v1[2], v1[3]);
                    *(u32x4*)(x2b + off + bj * HALF) = w; }
                s += __shfl_xor(s, 16); s += __shfl_xor(s, 32);
                if (fq == 0) ss[(size_t)row * 16 + u.pn * 4 + wc] = s; }
    }
};
struct PanelOrder {
    int c;
    __device__ __forceinline__ bool next(int i, Unit& u) const {
        if (i < 2) { const int xcd = c & 7, slot = c >> 3; u.pm = 64 * i + 8 * xcd + (slot & 7); u.pn = slot >> 3; u.hoff = 0; u.half = 0; return true; }
        return false;
    }
    __device__ __forceinline__ void a_ready(const Unit&) const {}
    __device__ __forceinline__ void done(const Unit&) const {}
};
struct TailOrder {
    int nN, c, count;
    __device__ __forceinline__ bool next(int i, Unit& u) const {
        if (i == 0 && c < count) { const int fu = c >> 1; u.pm = 128 + fu / nN; u.pn = fu % nN; u.hoff = (c & 1) * HALF; u.half = 1; return true; }
        return false;
    }
    __device__ __forceinline__ void a_ready(const Unit&) const {}
    __device__ __forceinline__ void done(const Unit&) const {}
};
struct PanelTail {
    int c;
    __device__ __forceinline__ bool next(int i, Unit& u) const {
        if (i < 2) { const int xcd = c & 7, slot = c >> 3; u.pm = 64 * i + 8 * xcd + (slot & 7); u.pn = slot >> 3; u.hoff = 0; u.half = 0; return true; }
        if (i == 2 && c < 32) { const int fu = c >> 1; u.pm = 128 + (fu >> 2); u.pn = fu & 3; u.hoff = (c & 1) * HALF; u.half = 1; return true; }
        return false;
    }
    __device__ __forceinline__ void a_ready(const Unit&) const {}
    __device__ __forceinline__ void done(const Unit&) const {}
};
struct PeA {
    int c;
    __device__ __forceinline__ bool next(int i, Unit& u) const {
        if (i == 0 && c >= 32) { const int cc = c - 32, xcd = cc & 7, slot = cc >> 3; u.pm = 8 * xcd + (slot & 7); u.pn = slot >> 3; u.hoff = 0; u.half = 0; return true; }
        return false;
    }
    __device__ __forceinline__ void a_ready(const Unit&) const {}
    __device__ __forceinline__ void done(const Unit&) const {}
};
struct PeB {
    int c;
    static __device__ __forceinline__ void unit_of(int id, Unit& u) { const int i = id >> 8, cc = id & 255, xcd = cc & 7, slot = cc >> 3; u.pm = 64 * i + 8 * xcd + (slot & 7); u.pn = slot >> 3; u.hoff = 0; u.half = 0; }
    __device__ __forceinline__ bool next(int i, Unit& u) const {
        if (c < 32) return false;
        if (i == 0) { unit_of(224 + (c - 32), u); return true; }
        if (i == 1 && c < 96) { unit_of(448 + (c - 32), u); return true; }
        if (i == 1 && c >= 96 && c < 128) { const int t = c - 96, fu = t >> 1; u.pm = 128 + (fu >> 2); u.pn = fu & 3; u.hoff = (t & 1) * HALF; u.half = 1; return true; }
        return false;
    }
    __device__ __forceinline__ void a_ready(const Unit&) const {}
    __device__ __forceinline__ void done(const Unit&) const {}
};
template <class Epi, class Sched, bool ALIGN_EPI = false, bool SP2 = false, bool HALFM = false>
__device__ __forceinline__ void gemm_phase(LAS unsigned char* lds, const Gemm g, const Sched& S, const Epi& E, const int wave_s) {
    int tid; { int l; asm volatile("v_mbcnt_lo_u32_b32 %0, -1, 0\n\tv_mbcnt_hi_u32_b32 %0, -1, %0" : "=v"(l)); tid = wave_s * 64 + l; }
    const int wid = __builtin_amdgcn_readfirstlane(tid >> 6), lane = tid & 63, wr = wid >> 2, wc = wid & 3, fr = lane & 15, fq = lane >> 4;
    const int K = g.K, nt = K / BK;
    unsigned voffA[2], voffB[2];
#pragma unroll
    for (int i = 0; i < 2; ++i) { int R, C; stage_rc(tid * 16 + i * 8192, R, C); const int Rb = Epi::PERM ? ((R & ~31) + perm32(R & 31)) : R;
        voffA[i] = (unsigned)(R * K + C) * 2u; voffB[i] = (unsigned)(Rb * K + C) * 2u; }
    const size_t kstep = (size_t)(BK * 2);
    const size_t hstep = (size_t)HALF * K * 2;
    const size_t tstep = 2 * hstep;
    const unsigned ldsw = (unsigned)wid * 1024u;
    const int aoff = lds_byte(wr * 64 + fr, fq * 8), boff = lds_byte(wc * 32 + fr, fq * 8);
#define PG8_SA(b, h) (((b) * 2 + (h)) * HTB)
#define PG8_SB(b, h) ((4 + (b) * 2 + (h)) * HTB)
#define PG8_STAGE(bufoff, gbase, voff) do { _Pragma("unroll") for (int _i = 0; _i < 2; ++_i) \
        __builtin_amdgcn_global_load_lds((const unsigned*)((const char*)(gbase) + (voff)[_i]), (LAS unsigned*)(lds + (bufoff) + ldsw + _i * 8192), 16, 0, 0); } while (0)
#define PG8_LDA(dst, b, h) do { _Pragma("unroll") for (int m = 0; m < 4; ++m) _Pragma("unroll") for (int k = 0; k < 2; ++k) dst[m][k] = *(const LAS bf16x8*)(lds + PG8_SA(b, h) + aoff + m * 2048 + k * 1024); } while (0)
#define PG8_LDB(dst, b, h) do { _Pragma("unroll") for (int n = 0; n < 2; ++n) _Pragma("unroll") for (int k = 0; k < 2; ++k) dst[n][k] = *(const LAS bf16x8*)(lds + PG8_SB(b, h) + boff + n * 2048 + k * 1024); } while (0)
#define PG8_MMA(ai, bj, At, Bt) do { __builtin_amdgcn_s_setprio(1); _Pragma("unroll") for (int m = 0; m < 4; ++m) _Pragma("unroll") for (int n = 0; n < 2; ++n) _Pragma("unroll") for (int k = 0; k < 2; ++k) \
        acc[ai][bj][m][n] = __builtin_amdgcn_mfma_f32_16x16x32_bf16(Bt[n][k], At[m][k], acc[ai][bj][m][n], 0, 0, 0); __builtin_amdgcn_s_setprio(0); } while (0)
#define PG8_WAIT_V(n) asm volatile("s_waitcnt vmcnt(" #n ")" ::: "memory")
#define PG8_WAIT_L(n) asm volatile("s_waitcnt lgkmcnt(" #n ")" ::: "memory")
#define PG8_BAR __builtin_amdgcn_s_barrier()
#define PG8_SCHED __builtin_amdgcn_sched_barrier(0)
    static_assert(!HALFM || SP2, "half-M units are implemented for the SP2 loop only");
    Unit cur{0, 0, 0, 0}, nxt{0, 0, 0, 0}; int ui = 0;
    if (!S.next(0, cur)) return;
    f32x4 acc[2][2][4][2];
    E.template init<HALFM>(acc, cur, wr, wc, fr, fq);
    bf16x8 At[4][2], B0[2][2], B1[2][2];
    bool chalf = HALFM && cur.half != 0; size_t cahs = chalf ? 0 : hstep;
    const char* cA = (const char*)g.A + (size_t)cur.pm * tstep + (HALFM ? (size_t)cur.hoff * K * 2 : 0); const char* cB = (const char*)g.Bt + (size_t)cur.pn * tstep;
    S.a_ready(cur);
    if constexpr (SP2) {
        PG8_STAGE(PG8_SB(0, 0), cB, voffB); PG8_STAGE(PG8_SB(0, 1), cB + hstep, voffB); PG8_STAGE(PG8_SA(0, 0), cA, voffA); PG8_STAGE(PG8_SA(0, 1), cA + cahs, voffA);
        if (wr == 1) PG8_BAR;
        PG8_WAIT_V(2); PG8_BAR;
        PG8_STAGE(PG8_SB(1, 0), cB + kstep, voffB); PG8_STAGE(PG8_SA(1, 0), cA + kstep, voffA); PG8_STAGE(PG8_SB(1, 1), cB + hstep + kstep, voffB);
        PG8_WAIT_V(6); PG8_BAR;
    } else {
        PG8_STAGE(PG8_SB(0, 0), cB, voffB); PG8_STAGE(PG8_SA(0, 0), cA, voffA); PG8_STAGE(PG8_SB(0, 1), cB + hstep, voffB); PG8_STAGE(PG8_SA(0, 1), cA + cahs, voffA);
        if (wr == 1) PG8_BAR;
        PG8_WAIT_V(4); PG8_BAR;
        PG8_STAGE(PG8_SB(1, 0), cB + kstep, voffB); PG8_STAGE(PG8_SA(1, 0), cA + kstep, voffA); PG8_STAGE(PG8_SB(1, 1), cB + hstep + kstep, voffB);
        PG8_WAIT_V(6); PG8_BAR;
    }
    for (;;) {
        const bool has_next = S.next(ui + 1, nxt);
        const bool nhalf = HALFM && has_next && nxt.half != 0; const size_t nahs = has_next ? (nhalf ? 0 : hstep) : cahs;
        const char* nA = has_next ? (const char*)g.A + (size_t)nxt.pm * tstep + (HALFM ? (size_t)nxt.hoff * K * 2 : 0) : cA; const char* nB = has_next ? (const char*)g.Bt + (size_t)nxt.pn * tstep : cB;
        for (int t = 0; t < nt; t += 2) {
            const bool last = (t == nt - 2);
            const char* a1 = cA + (size_t)(t + 1) * kstep;
            const char* a2 = last ? nA : cA + (size_t)(t + 2) * kstep; const char* b2 = last ? nB : cB + (size_t)(t + 2) * kstep;
            const char* a3 = a2 + kstep; const char* b3 = b2 + kstep; const size_t ahs2 = last ? nahs : cahs;
            if (last && has_next) S.a_ready(nxt);
            if constexpr (SP2) {
            PG8_LDB(B0, 0, 0); PG8_LDB(B1, 0, 1); PG8_SCHED; PG8_LDA(At, 0, 0); PG8_STAGE(PG8_SA(1, 1), a1 + cahs, voffA);
            PG8_WAIT_V(8); PG8_WAIT_L(0); PG8_BAR; PG8_MMA(0, 0, At, B0); PG8_MMA(0, 1, At, B1); PG8_BAR; PG8_SCHED;
            if (!chalf) PG8_LDA(At, 0, 1); PG8_STAGE(PG8_SB(0, 0), b2, voffB); PG8_STAGE(PG8_SB(0, 1), b2 + hstep, voffB); PG8_STAGE(PG8_SA(0, 0), a2, voffA);
            PG8_WAIT_V(8); PG8_WAIT_L(0); PG8_BAR; if (!chalf) { PG8_MMA(1, 0, At, B0); PG8_MMA(1, 1, At, B1); } PG8_BAR; PG8_SCHED;
            PG8_LDB(B0, 1, 0); PG8_LDB(B1, 1, 1); PG8_SCHED; PG8_LDA(At, 1, 0); PG8_STAGE(PG8_SA(0, 1), a2 + ahs2, voffA);
            PG8_WAIT_V(8); PG8_WAIT_L(0); PG8_BAR; PG8_MMA(0, 0, At, B0); PG8_MMA(0, 1, At, B1); PG8_BAR; PG8_SCHED;
            if (!chalf) PG8_LDA(At, 1, 1); PG8_STAGE(PG8_SB(1, 0), b3, voffB); PG8_STAGE(PG8_SB(1, 1), b3 + hstep, voffB); PG8_STAGE(PG8_SA(1, 0), a3, voffA);
            PG8_WAIT_V(8); PG8_WAIT_L(0); PG8_BAR; if (!chalf) { PG8_MMA(1, 0, At, B0); PG8_MMA(1, 1, At, B1); } PG8_BAR; PG8_SCHED;
            } else {
            PG8_LDB(B0, 0, 0); PG8_SCHED; PG8_LDA(At, 0, 0); PG8_STAGE(PG8_SA(1, 1), a1 + cahs, voffA);
            PG8_WAIT_L(8); PG8_BAR; PG8_WAIT_L(0); PG8_MMA(0, 0, At, B0); PG8_BAR; PG8_SCHED;
            PG8_LDB(B1, 0, 1); PG8_STAGE(PG8_SB(0, 0), b2, voffB);
            PG8_BAR; PG8_WAIT_L(0); PG8_MMA(0, 1, At, B1); PG8_BAR;
            PG8_LDA(At, 0, 1); PG8_STAGE(PG8_SA(0, 0), a2, voffA);
            PG8_BAR; PG8_WAIT_L(0); PG8_MMA(1, 0, At, B0); PG8_BAR; PG8_SCHED;
            PG8_STAGE(PG8_SB(0, 1), b2 + hstep, voffB);
            PG8_WAIT_V(6); PG8_BAR; PG8_MMA(1, 1, At, B1); PG8_BAR;
            PG8_LDB(B0, 1, 0); PG8_SCHED; PG8_LDA(At, 1, 0); PG8_STAGE(PG8_SA(0, 1), a2 + ahs2, voffA);
            PG8_WAIT_L(8); PG8_BAR; PG8_WAIT_L(0); PG8_MMA(0, 0, At, B0); PG8_BAR; PG8_SCHED;
            PG8_LDB(B1, 1, 1); PG8_STAGE(PG8_SB(1, 0), b3, voffB);
            PG8_BAR; PG8_WAIT_L(0); PG8_MMA(0, 1, At, B1); PG8_BAR;
            PG8_LDA(At, 1, 1); PG8_STAGE(PG8_SA(1, 0), a3, voffA);
            PG8_BAR; PG8_WAIT_L(0); PG8_MMA(1, 0, At, B0); PG8_BAR; PG8_SCHED;
            PG8_STAGE(PG8_SB(1, 1), b3 + hstep, voffB);
            PG8_WAIT_V(6); PG8_BAR; PG8_MMA(1, 1, At, B1); PG8_BAR;
            }
        }
        if constexpr (ALIGN_EPI) { if (wr == 0) PG8_BAR; }
        E.template store<HALFM>(acc, cur, wr, wc, fr, fq); S.done(cur);
        if (!has_next) break;
        E.template init<HALFM>(acc, nxt, wr, wc, fr, fq);
        cur = nxt; cA = nA; cB = nB; ++ui; chalf = nhalf; cahs = nahs;
        if constexpr (ALIGN_EPI) { if (wr == 1) PG8_BAR; }
    }
    PG8_WAIT_V(0);
    if constexpr (!ALIGN_EPI) { if (wr == 0) PG8_BAR; }
    PG8_BAR;
#undef PG8_SA
#undef PG8_SB
#undef PG8_STAGE
#undef PG8_LDA
#undef PG8_LDB
#undef PG8_MMA
#undef PG8_WAIT_V
#undef PG8_WAIT_L
#undef PG8_BAR
#undef PG8_SCHED
}
}

__device__ __forceinline__ int lane_id_asm() { int l; asm volatile("v_mbcnt_lo_u32_b32 %0, -1, 0\n\tv_mbcnt_hi_u32_b32 %0, -1, %0" : "=v"(l)); return l; }
__device__ __forceinline__ int opaque_tid(int wave_s) { return wave_s * 64 + lane_id_asm(); }
#define LDS_WAIT() asm volatile("s_waitcnt lgkmcnt(0)" ::: "memory")
__device__ __forceinline__ unsigned f2bf(float f) { unsigned u = __float_as_uint(f); return (u + 0x7fffu + ((u >> 16) & 1u)) >> 16; }
__device__ __forceinline__ unsigned pk2(float lo, float hi) { return pg8::cvt_pk_bf16(lo, hi); }
__device__ __forceinline__ float bf2f(bf16_t v) { return __uint_as_float(((unsigned)v) << 16); }
__device__ __forceinline__ float dpp_add(float v, const int ctrl_is) {
    return v;
}
template <int CTRL> __device__ __forceinline__ float dpp_mov(float v) { return __int_as_float(__builtin_amdgcn_update_dpp(0, __float_as_int(v), CTRL, 0xf, 0xf, true)); }
__device__ __forceinline__ float wave_sum(float v) {
    v += dpp_mov<0xB1>(v);
    v += dpp_mov<0x4E>(v);
    v += dpp_mov<0x141>(v);
    v += dpp_mov<0x140>(v);
    v += __shfl_xor(v, 16); v += __shfl_xor(v, 32);
    return v;
}
__device__ __forceinline__ float fexp(float x) { return __builtin_amdgcn_exp2f(x * 1.44269504088896341f); }
__device__ __forceinline__ float sigm(float x) { return __builtin_amdgcn_rcpf(1.0f + fexp(-x)); }
typedef __bf16 bf16x2_t __attribute__((ext_vector_type(2)));
__device__ __forceinline__ unsigned cvt_pk_native(float lo, float hi) { const f32x2 v = {lo, hi}; return __builtin_bit_cast(unsigned, __builtin_convertvector(v, bf16x2_t)); }
__device__ __forceinline__ unsigned short f2bf_hw(float x) { return (unsigned short)pg8::cvt_pk_bf16(x, x); }
__device__ __forceinline__ float one_minus_exp(float x, float e) {
    const float p = -x * (1.0f + x * (0.5f + x * (1.0f / 6.0f + x * (1.0f / 24.0f + x * (1.0f / 120.0f + x * (1.0f / 720.0f))))));
    const float q = 1.0f - e * e;
    return x > -0.25f ? p : q;
}

namespace mx {
constexpr int XS = 144;
constexpr int PS = 272;
constexpr int L_XLR = 0;
constexpr int L_XPR = L_XLR + 144 * XS;
constexpr int L_FL = L_XPR + 144 * PS;
constexpr int L_FP = L_FL + 64 * XS;
constexpr int L_AX = L_FP + 64 * XS;
constexpr int L_AP = L_AX + 64 * XS;
constexpr int L_OUT = L_AP + 64 * PS;
constexpr int L_COMP = L_OUT + 64 * XS;
constexpr int L_CARRY = L_COMP + 512;
constexpr int L_END = L_CARRY + 512;
static_assert(L_END <= LDS_BYTES - 256, "mixer LDS map");

#define MX_BAR() do { asm volatile("s_waitcnt lgkmcnt(0)" ::: "memory"); __builtin_amdgcn_s_barrier(); asm volatile("" ::: "memory"); } while (0)

__device__ __forceinline__ float lo16(unsigned v) { return __uint_as_float(v << 16); }
__device__ __forceinline__ float hi16(unsigned v) { return __uint_as_float(v & 0xffff0000u); }
__device__ __forceinline__ float ldbf(const LAS unsigned char* p) { return __uint_as_float(((unsigned)*(const LAS unsigned short*)p) << 16); }

template <int W, int CB>
__device__ __forceinline__ void pooled_rows(const LAS unsigned char* pxr, LAS unsigned char* pap, int pos_w0) {
    unsigned v[W + 7];
#pragma unroll
    for (int k = 0; k < W + 7; ++k) v[k] = *(const LAS unsigned*)(pxr + (CB - (W - 1) + k) * PS);
    f32x2 sv = (f32x2){0.f, 0.f};
#pragma unroll
    for (int k = 0; k < W - 1; ++k) sv += (f32x2){lo16(v[k]), hi16(v[k])};
    const bool early = pos_w0 + 1 < W;
#pragma unroll
    for (int i = 0; i < 8; ++i) {
        const f32x2 z = (f32x2){lo16(v[i + W - 1]), hi16(v[i + W - 1])};
        sv += z;
        float rc = 1.0f / (float)W;
        if (early) { const int pos = pos_w0 + i; const int cnt = (pos + 1 < W) ? pos + 1 : W; rc = __builtin_amdgcn_rcpf((float)cnt); }
        const f32x2 o = sv * rc - z;
        *(LAS unsigned*)(pap + i * PS) = pg8::cvt_pk_bf16(o[0], o[1]);
        sv -= (f32x2){lo16(v[i]), hi16(v[i])};
    }
}

struct MixP {
    const bf16_t* proj; bf16_t* merged; float* out;
    const float* state_conv; const float* state_lru; const float* state_pool;
    const float* conv_w; const float* conv_b; const float* b_rg_a; const float* b_rg_i; const float* lru_lambda; const float* b_pool; const float* pool_scale;
    const bf16_t* wt_ra; const bf16_t* wt_ri; const bf16_t* wt_pool;
};
struct MixC {
    bf16x8 wfa[2], wfi[2], wfp[4];
    float cw0, cw1, cw2, cw3, cb, ba, bi, c7, bp, psc;
    int hf, fq, fr, g, nmt, Tc, wave;
    const LAS unsigned char* pxl;
    LAS unsigned char* paxw;
    const LAS unsigned char* paxr;
    const LAS unsigned char* papr;
    const LAS unsigned char* pfl;
    LAS unsigned char* pout;
    bf16x8 bandA; int W;
    const LAS unsigned char* ptr;
    LAS unsigned char* papw;
    LAS unsigned char* pcomp; LAS unsigned char* pcarry;
};

template <int CB>
__device__ __forceinline__ void mixer_chunk(LAS unsigned char* lds, const MixC& C, const int ck, const int posc,
                                            const u32x4& sXL, const u32x4& sFL, const u32x4& sFP, const u32x4& sXP0, const u32x4& sXP1, const int srow, const int spc, const int xrow, const int xpc) {
    constexpr int NB = (CB == 16) ? 80 : 16;
    const int hf = C.hf, fq = C.fq;
    float xc[2][4];
#ifndef REP_S1
#define REP_S1 1
#endif
#ifndef REP_S2
#define REP_S2 1
#endif
#ifndef REP_S3
#define REP_S3 1
#endif
    for (int rep1 = 0; rep1 < REP_S1; ++rep1) {
    asm volatile("" ::: "memory");
    unsigned short xr[2][7];
#pragma unroll
    for (int mi = 0; mi < 2; ++mi)
#pragma unroll
        for (int i = 0; i < 7; ++i) xr[mi][i] = *(const LAS unsigned short*)(C.pxl + (CB + 16 * mi + i - 3) * XS);
    typedef short v4s __attribute__((ext_vector_type(4)));
    v4s lo[4], hi[4];
#pragma unroll
    for (int nn = 0; nn < 4; ++nn) { lo[nn] = __builtin_amdgcn_ds_read_tr16_b64_v4i16((LAS v4s*)(C.ptr + (CB - 16) * PS + 32 * nn)); hi[nn] = __builtin_amdgcn_ds_read_tr16_b64_v4i16((LAS v4s*)(C.ptr + (CB - 12) * PS + 32 * nn)); }
    asm volatile("s_waitcnt lgkmcnt(0)" ::: "memory");
    bf16x8 bA = C.bandA;
    if (posc == 0 && (C.wave & 3) == 0) {
        const int cn = (C.fr + 1 < C.W) ? C.fr + 1 : C.W; const float rc = __builtin_amdgcn_rcpf((float)cn); short bw[8];
#pragma unroll
        for (int jj = 0; jj < 8; ++jj) { const int dd = C.fr + 16 - (8 * C.fq + jj); const float cf = ((dd >= 0 && dd < C.W) ? rc : 0.f) - (dd == 0 ? 1.0f : 0.f); bw[jj] = (short)f2bf_hw(cf); }
        bA = (bf16x8){bw[0], bw[1], bw[2], bw[3], bw[4], bw[5], bw[6], bw[7]};
    }
    f32x4 q[4];
#pragma unroll
    for (int nn = 0; nn < 4; ++nn) { const bf16x8 zf = (bf16x8){lo[nn][0], lo[nn][1], lo[nn][2], lo[nn][3], hi[nn][0], hi[nn][1], hi[nn][2], hi[nn][3]};
        q[nn] = __builtin_amdgcn_mfma_f32_16x16x32_bf16(bA, zf, (f32x4){0.f, 0.f, 0.f, 0.f}, 0, 0, 0); }
#pragma unroll
    for (int mi = 0; mi < 2; ++mi) if (2 * hf + mi < C.nmt) {
        float xv[7];
#pragma unroll
        for (int i = 0; i < 7; ++i) xv[i] = __uint_as_float(((unsigned)xr[mi][i]) << 16);
#pragma unroll
        for (int j = 0; j < 4; j += 2) {
            f32x2 a = (f32x2){xv[j], xv[j + 1]} * C.cw0 + C.cb;
            a = (f32x2){xv[j + 1], xv[j + 2]} * C.cw1 + a; a = (f32x2){xv[j + 2], xv[j + 3]} * C.cw2 + a; a = (f32x2){xv[j + 3], xv[j + 4]} * C.cw3 + a;
            xc[mi][j] = a[0]; xc[mi][j + 1] = a[1];
            const unsigned pk = pg8::cvt_pk_bf16(a[0], a[1]);
            *(LAS unsigned short*)(C.paxw + (16 * mi + j) * XS) = (unsigned short)pk; *(LAS unsigned short*)(C.paxw + (16 * mi + j + 1) * XS) = (unsigned short)(pk >> 16); }
    }
    if (16 * (C.wave & 3) < C.Tc) {
#pragma unroll
        for (int nn = 0; nn < 4; ++nn) {
            const unsigned p01 = cvt_pk_native(q[nn][0], q[nn][1]), p23 = cvt_pk_native(q[nn][2], q[nn][3]);
            *(LAS unsigned short*)(C.papw + 32 * nn) = (unsigned short)p01; *(LAS unsigned short*)(C.papw + PS + 32 * nn) = (unsigned short)(p01 >> 16);
            *(LAS unsigned short*)(C.papw + 2 * PS + 32 * nn) = (unsigned short)p23; *(LAS unsigned short*)(C.papw + 3 * PS + 32 * nn) = (unsigned short)(p23 >> 16);
        }
    }
    }
    MX_BAR();
    float av[2][4], bv[2][4], fl[2][4], pl[2][4], PA[2], PB[2], TA[2], TB[2], LA[2], LB[2];
    bf16x8 afx[2][2], afp[2][4]; unsigned flr[2][4], fpr[2][4];
    for (int rep2 = 0; rep2 < REP_S2; ++rep2) {
    asm volatile("" ::: "memory");
#pragma unroll
    for (int mi = 0; mi < 2; ++mi) {
#pragma unroll
        for (int ks = 0; ks < 2; ++ks) afx[mi][ks] = *(const LAS bf16x8*)(C.paxr + 16 * mi * XS + 64 * ks);
#pragma unroll
        for (int ks = 0; ks < 4; ++ks) afp[mi][ks] = *(const LAS bf16x8*)(C.papr + 16 * mi * PS + 64 * ks);
#pragma unroll
        for (int j = 0; j < 4; ++j) { flr[mi][j] = *(const LAS unsigned short*)(C.pfl + (16 * mi + j) * XS); fpr[mi][j] = *(const LAS unsigned short*)(C.pfl + (L_FP - L_FL) + (16 * mi + j) * XS); }
    }
    asm volatile("s_waitcnt lgkmcnt(0)" ::: "memory");
#pragma unroll
    for (int mi = 0; mi < 2; ++mi) {
        {
            f32x4 accA = (f32x4){0.f, 0.f, 0.f, 0.f}, accB = accA, accP = accA;
#pragma unroll
            for (int ks = 0; ks < 2; ++ks) {
                accA = __builtin_amdgcn_mfma_f32_16x16x32_bf16(afx[mi][ks], C.wfa[ks], accA, 0, 0, 0);
                accB = __builtin_amdgcn_mfma_f32_16x16x32_bf16(afx[mi][ks], C.wfi[ks], accB, 0, 0, 0); }
#pragma unroll
            for (int ks = 0; ks < 4; ++ks) accP = __builtin_amdgcn_mfma_f32_16x16x32_bf16(afp[mi][ks], C.wfp[ks], accP, 0, 0, 0);
#pragma unroll
            for (int j = 0; j < 4; j += 2) {
                const f32x2 za = (f32x2){accA[j], accA[j + 1]} + C.ba, zi = (f32x2){accB[j], accB[j + 1]} + C.bi;
                const f32x2 da = (f32x2){__builtin_amdgcn_exp2f(za[0]), __builtin_amdgcn_exp2f(za[1])} + 1.0f, di = (f32x2){__builtin_amdgcn_exp2f(zi[0]), __builtin_amdgcn_exp2f(zi[1])} + 1.0f;
                const f32x2 r = (f32x2){__builtin_amdgcn_rcpf(da[0]), __builtin_amdgcn_rcpf(da[1])}, ig = (f32x2){__builtin_amdgcn_rcpf(di[0]), __builtin_amdgcn_rcpf(di[1])};
                const f32x2 la = r * C.c7;
                const f32x2 a = (f32x2){__builtin_amdgcn_exp2f(la[0]), __builtin_amdgcn_exp2f(la[1])};
                const f32x2 om = 1.0f - a * a;
                f32x2 mult = (f32x2){__builtin_amdgcn_sqrtf(om[0]), __builtin_amdgcn_sqrtf(om[1])};
                if (mi == 0 && j == 0) mult[0] = (posc == 0 && hf == 0 && fq == 0) ? 1.0f : mult[0];
                const f32x2 bq = mult * (ig * (f32x2){xc[mi][j], xc[mi][j + 1]});
                av[mi][j] = a[0]; av[mi][j + 1] = a[1]; bv[mi][j] = bq[0]; bv[mi][j + 1] = bq[1];
                fl[mi][j] = __uint_as_float(flr[mi][j] << 16); fl[mi][j + 1] = __uint_as_float(flr[mi][j + 1] << 16);
                const f32x2 pq = ((f32x2){accP[j], accP[j + 1]} + C.bp) * (f32x2){__uint_as_float(fpr[mi][j] << 16), __uint_as_float(fpr[mi][j + 1] << 16)};
                pl[mi][j] = pq[0]; pl[mi][j + 1] = pq[1];
            }
            const bool mv = 2 * hf + mi < C.nmt;
            LA[mi] = mv ? (av[mi][0] * av[mi][1]) * (av[mi][2] * av[mi][3]) : 1.0f;
            LB[mi] = mv ? ((bv[mi][0] * av[mi][1] + bv[mi][1]) * av[mi][2] + bv[mi][2]) * av[mi][3] + bv[mi][3] : 0.0f;
        }
    }
    {
        const int fr = C.fr;
        float A0[2], A1[2], A2[2], A3[2], B0[2], B1[2], B2[2], B3[2];
#pragma unroll
        for (int mi = 0; mi < 2; ++mi) { A0[mi] = __shfl(LA[mi], fr); A1[mi] = __shfl(LA[mi], fr + 16); A2[mi] = __shfl(LA[mi], fr + 32); A3[mi] = __shfl(LA[mi], fr + 48);
            B0[mi] = __shfl(LB[mi], fr); B1[mi] = __shfl(LB[mi], fr + 16); B2[mi] = __shfl(LB[mi], fr + 32); B3[mi] = __shfl(LB[mi], fr + 48); }
#pragma unroll
        for (int mi = 0; mi < 2; ++mi) {
            const float p2a = A1[mi] * A0[mi], p2b = A1[mi] * B0[mi] + B1[mi], p3a = A2[mi] * p2a, p3b = A2[mi] * p2b + B2[mi];
            TA[mi] = A3[mi] * p3a; TB[mi] = A3[mi] * p3b + B3[mi];
            PA[mi] = fq == 0 ? 1.f : (fq == 1 ? A0[mi] : (fq == 2 ? p2a : p3a));
            PB[mi] = fq == 0 ? 0.f : (fq == 1 ? B0[mi] : (fq == 2 ? p2b : p3b));
        }
    }
    }
    const float AW = TA[0] * TA[1], BW = TB[0] * TA[1] + TB[1];
    if (hf == 0 && fq == 0) { *(LAS f32x2*)(C.pcomp) = (f32x2){AW, BW}; }
    MX_BAR();
    for (int rep3 = 0; rep3 < REP_S3; ++rep3) {
    asm volatile("" ::: "memory");
        const float hprev = *(const LAS float*)(C.pcarry + (ck & 1) * 256);
        const f32x2 c0 = *(const LAS f32x2*)(C.pcomp);
        asm volatile("s_waitcnt lgkmcnt(0)" ::: "memory");
        const float hst = hf == 0 ? hprev : c0[0] * hprev + c0[1];
        if (hf == 1 && fq == 0) *(LAS float*)(C.pcarry + ((ck + 1) & 1) * 256) = AW * hst + BW;
#pragma unroll
        for (int mi = 0; mi < 2; ++mi) {
            const float hin = mi == 0 ? hst : TA[0] * hst + TB[0];
            const float h0 = av[mi][0] * (PA[mi] * hin + PB[mi]) + bv[mi][0], h1 = av[mi][1] * h0 + bv[mi][1], h2 = av[mi][2] * h1 + bv[mi][2], h3 = av[mi][3] * h2 + bv[mi][3];
            const f32x2 o01 = (f32x2){h0, h1} * (f32x2){fl[mi][0], fl[mi][1]} + (f32x2){pl[mi][0], pl[mi][1]}, o23 = (f32x2){h2, h3} * (f32x2){fl[mi][2], fl[mi][3]} + (f32x2){pl[mi][2], pl[mi][3]};
            const unsigned p01 = cvt_pk_native(o01[0], o01[1]), p23 = cvt_pk_native(o23[0], o23[1]);
            if (2 * hf + mi < C.nmt) {
                *(LAS unsigned short*)(C.pout + (16 * mi + 0) * XS) = (unsigned short)p01; *(LAS unsigned short*)(C.pout + (16 * mi + 1) * XS) = (unsigned short)(p01 >> 16);
                *(LAS unsigned short*)(C.pout + (16 * mi + 2) * XS) = (unsigned short)p23; *(LAS unsigned short*)(C.pout + (16 * mi + 3) * XS) = (unsigned short)(p23 >> 16); }
        }
        *(LAS u32x4*)(lds + L_XLR + (NB + srow) * XS + spc * 16) = sXL; *(LAS u32x4*)(lds + L_FL + srow * XS + spc * 16) = sFL; *(LAS u32x4*)(lds + L_FP + srow * XS + spc * 16) = sFP;
        *(LAS u32x4*)(lds + L_XPR + (NB + xrow) * PS + xpc * 16) = sXP0; *(LAS u32x4*)(lds + L_XPR + (NB + xrow + 32) * PS + xpc * 16) = sXP1;
        if (NB == 80) {
            if (srow >= 48) *(LAS u32x4*)(lds + L_XLR + (srow - 48) * XS + spc * 16) = sXL;
            if (xrow >= 16) *(LAS u32x4*)(lds + L_XPR + (xrow - 16) * PS + xpc * 16) = sXP1;
        }
    }
    MX_BAR();
}

__device__ __forceinline__ void mixer_item(LAS unsigned char* lds, const MixP& P, const int it, const int wave_s) {
    const int tid = opaque_tid(wave_s), lane = tid & 63, wave = __builtin_amdgcn_readfirstlane(tid >> 6), fr = lane & 15, fq = lane >> 4;
    const bool prm = it < 256;
    const int b = prm ? (it >> 4) : ((it - 256) >> 4), h = it & 15, g = h >> 2;
    const int T = prm ? SEQ : DS; const int grow0 = prm ? b * SEQ : NP + b * DS; const int pos0 = prm ? 0 : PAST;
    const int nck = (T + 63) >> 6; const int Tc = T < 64 ? T : 64; const int nmt = Tc >> 4;
    const int n = wave & 3, hf = wave >> 2;
    const int c16 = 16 * n + fr;
    const int d = h * 64 + c16;
    const int srow = tid >> 3, spc = tid & 7, xrow = tid >> 4, xpc = tid & 15;
    const int srow_c = srow < Tc ? srow : Tc - 1, xrow_c0 = xrow < Tc ? xrow : Tc - 1, xrow_c1 = (xrow + 32) < Tc ? (xrow + 32) : Tc - 1;
    MixC C;
    { const bf16_t* wa = P.wt_ra + h * 4096 + c16 * 64 + 8 * fq; const bf16_t* wi = P.wt_ri + h * 4096 + c16 * 64 + 8 * fq;
      C.wfa[0] = *(const bf16x8*)(wa); C.wfa[1] = *(const bf16x8*)(wa + 32); C.wfi[0] = *(const bf16x8*)(wi); C.wfi[1] = *(const bf16x8*)(wi + 32);
      const bf16_t* wp = P.wt_pool + g * 32768 + ((h & 3) * 64 + c16) * 128 + 8 * fq;
      C.wfp[0] = *(const bf16x8*)(wp); C.wfp[1] = *(const bf16x8*)(wp + 32); C.wfp[2] = *(const bf16x8*)(wp + 64); C.wfp[3] = *(const bf16x8*)(wp + 96); }
    C.cw0 = P.conv_w[0 * D + d]; C.cw1 = P.conv_w[1 * D + d]; C.cw2 = P.conv_w[2 * D + d]; C.cw3 = P.conv_w[3 * D + d]; C.cb = P.conv_b[d];
    C.ba = -1.44269504088896341f * P.b_rg_a[d]; C.bi = -1.44269504088896341f * P.b_rg_i[d];
    C.c7 = P.lru_lambda[d];
    C.psc = P.pool_scale[d]; C.bp = P.b_pool[g * 256 + (h & 3) * 64 + c16] * C.psc;
    C.hf = hf; C.fq = fq; C.fr = fr; C.g = g; C.nmt = nmt; C.Tc = Tc; C.wave = wave;
    C.pxl = lds + L_XLR + (32 * hf + 4 * fq) * XS + c16 * 2;
    C.paxw = lds + L_AX + (32 * hf + 4 * fq) * XS + c16 * 2;
    C.paxr = lds + L_AX + (32 * hf + fr) * XS + 16 * fq;
    C.papr = lds + L_AP + (32 * hf + fr) * PS + 16 * fq;
    C.pfl = lds + L_FL + (32 * hf + 4 * fq) * XS + c16 * 2;
    C.pout = lds + L_OUT + (32 * hf + 4 * fq) * XS + c16 * 2;
    C.W = 2 << g;
    { short bw[8];
#pragma unroll
      for (int jj = 0; jj < 8; ++jj) { const int dd = fr + 16 - (8 * fq + jj); const float cf = ((dd >= 0 && dd < C.W) ? 1.0f / (float)C.W : 0.f) - (dd == 0 ? 1.0f : 0.f); bw[jj] = (short)f2bf(cf); }
      C.bandA = (bf16x8){bw[0], bw[1], bw[2], bw[3], bw[4], bw[5], bw[6], bw[7]}; }
    C.ptr = lds + L_XPR + (16 * (wave & 3) + 8 * fq + (fr >> 2)) * PS + (fr & 3) * 8 + (wave >> 2) * 128;
    C.papw = lds + L_AP + (16 * (wave & 3) + 4 * fq) * PS + ((wave >> 2) * 64 + fr) * 2;
    if (tid < 64) *(LAS unsigned*)(lds + L_XPR + tid * 4) = 0u;
    C.pcomp = lds + L_COMP + c16 * 8; C.pcarry = lds + L_CARRY + c16 * 4;
    if (hf == 0 && fq == 0) *(LAS float*)(C.pcarry) = prm ? 0.f : P.state_lru[(size_t)b * D + d];
    if (tid < 192) { const int r = tid >> 6, c = tid & 63; const float v = prm ? 0.f : P.state_conv[((size_t)b * 3 + r) * D + h * 64 + c];
        *(LAS unsigned short*)(lds + L_XLR + (13 + r) * XS + c * 2) = (unsigned short)f2bf(v); }
    for (int e = tid; e < 15 * 128; e += NWAVES * 64) { const int r = e >> 7, c = e & 127; const float v = prm ? 0.f : P.state_pool[((size_t)b * 15 + r) * DPOOL + g * 128 + c];
        *(LAS unsigned short*)(lds + L_XPR + (1 + r) * PS + c * 2) = (unsigned short)f2bf(v); }
    u32x4 sXL, sFL, sFP, sXP0, sXP1;
#define MX_LOAD(tc) do { const bf16_t* pr = P.proj + ((size_t)h * M + grow0 + (tc) + srow_c) * 64 + spc * 8; \
        sXL = __builtin_nontemporal_load((const u32x4*)(pr + (size_t)M * P_XL)); sFL = __builtin_nontemporal_load((const u32x4*)(pr + (size_t)M * P_FL)); sFP = __builtin_nontemporal_load((const u32x4*)(pr + (size_t)M * P_FP)); \
        const bf16_t* px = P.proj + (size_t)M * P_XP + ((size_t)g * M + grow0 + (tc)) * 128 + xpc * 8; \
        sXP0 = *(const u32x4*)(px + (size_t)xrow_c0 * 128); sXP1 = *(const u32x4*)(px + (size_t)xrow_c1 * 128); } while (0)
#define MX_STORE(tc) do { if (srow < Tc) { const u32x4 o = *(const LAS u32x4*)(lds + L_OUT + srow * XS + spc * 16); \
        *(u32x4*)(P.merged + (size_t)(grow0 + (tc) + srow) * D + h * 64 + spc * 8) = o; } } while (0)
    MX_LOAD(0);
    *(LAS u32x4*)(lds + L_XLR + (16 + srow) * XS + spc * 16) = sXL; *(LAS u32x4*)(lds + L_FL + srow * XS + spc * 16) = sFL; *(LAS u32x4*)(lds + L_FP + srow * XS + spc * 16) = sFP;
    *(LAS u32x4*)(lds + L_XPR + (16 + xrow) * PS + xpc * 16) = sXP0; *(LAS u32x4*)(lds + L_XPR + (16 + xrow + 32) * PS + xpc * 16) = sXP1;
    MX_BAR();
    for (int ck = 0; ck < nck; ck += 2) {
        const int tch = ck * 64;
        { const int tn = (ck + 1 < nck) ? tch + 64 : tch; MX_LOAD(tn); }
        mixer_chunk<16>(lds, C, ck, pos0 + tch, sXL, sFL, sFP, sXP0, sXP1, srow, spc, xrow, xpc);
        MX_STORE(tch);
        if (ck + 1 < nck) {
            { const int tn = (ck + 2 < nck) ? tch + 128 : tch + 64; MX_LOAD(tn); }
            mixer_chunk<80>(lds, C, ck + 1, pos0 + tch + 64, sXL, sFL, sFP, sXP0, sXP1, srow, spc, xrow, xpc);
            MX_STORE(tch + 64);
        }
    }
    {
        const int LB = ((nck - 1) & 1) ? 80 : 16;
        if (tid < 192) { const int r = tid >> 6, c = tid & 63;
            P.out[(prm ? O_CONV_P : O_CONV_S) + ((size_t)b * 3 + r) * D + h * 64 + c] = ldbf(lds + L_XLR + (LB + Tc - 3 + r) * XS + c * 2); }
        if ((h & 3) == 0) for (int e = tid; e < 15 * 128; e += NWAVES * 64) { const int r = e >> 7, c = e & 127;
            P.out[(prm ? O_POOL_P : O_POOL_S) + ((size_t)b * 15 + r) * DPOOL + g * 128 + c] = ldbf(lds + L_XPR + (LB + Tc - 15 + r) * PS + c * 2); }
        if (hf == 0 && fq == 0) P.out[(prm ? O_LRU_P : O_LRU_S) + (size_t)b * D + d] = *(const LAS float*)(C.pcarry + (nck & 1) * 256);
    }
    MX_BAR();
#undef MX_LOAD
#undef MX_STORE
}
#undef MX_BAR
}

#define XB_TMO      128
#define XB_XCNT(j)  (256  + 64 * (j))
#define XB_XSUB(j)  (1280 + 64 * (j))
#define XB_XGEN(j)  (2304 + 64 * (j))
#define XB_TOP      3328
#define XB_TOPGEN   3392
#define XCD_BAR_WORDS 3456
#define XB_SPIN_CAP (1u << 18)
__device__ __forceinline__ unsigned xb_ld(unsigned* p)              { return __hip_atomic_load(p, __ATOMIC_RELAXED, __HIP_MEMORY_SCOPE_AGENT); }
__device__ __forceinline__ unsigned xb_add(unsigned* p, unsigned v) { return __hip_atomic_fetch_add(p, v, __ATOMIC_RELAXED, __HIP_MEMORY_SCOPE_AGENT); }
__device__ __forceinline__ unsigned xb_xcc_id() { return (unsigned)__builtin_amdgcn_s_getreg((3 << 11) | 20) & 0xFu; }
#define XB_SPIN(cond, bar) do { unsigned _sp = 0; while (cond) { __builtin_amdgcn_s_sleep(1); \
    if ((++_sp & 255u) == 0u) { if (xb_ld(&(bar)[XB_TMO])) break; if (_sp > XB_SPIN_CAP) { atomicAdd(&(bar)[XB_TMO], 1u); break; } } } } while (0)
struct XcdBarrier { unsigned* bar; unsigned x; volatile LAS unsigned* st; };
__device__ __forceinline__ XcdBarrier xcd_barrier_post(unsigned* bar, volatile LAS unsigned* st) {
    XcdBarrier b; b.bar = bar; b.x = xb_xcc_id(); b.st = st;
    if (threadIdx.x == 0) { const unsigned o = xb_add(&bar[XB_XCNT(b.x)], 1u); st[3] = (o == 0u) ? 1u : 0u; }
    return b;
}
__device__ __forceinline__ void xcd_barrier_complete(unsigned* bar, unsigned x, unsigned& nloc, unsigned& nx) {
    const unsigned G = gridDim.x * gridDim.y * gridDim.z;
    unsigned sum, cnt, mine, sp = 0u;
    for (;;) {
        sum = 0u; cnt = 0u; mine = 0u;
#pragma unroll
        for (unsigned j = 0; j < 16; ++j) { const unsigned c = xb_ld(&bar[XB_XCNT(j)]); sum += c; cnt += (c > 0u) ? 1u : 0u; mine = (j == x) ? c : mine; }
        if (sum == G) break;
        __builtin_amdgcn_s_sleep(1);
        if ((++sp & 255u) == 0u) { if (xb_ld(&bar[XB_TMO])) break; if (sp > XB_SPIN_CAP) { atomicAdd(&bar[XB_TMO], 1u); break; } }
    }
    nloc = mine > 0u ? mine : 1u; nx = cnt > 0u ? cnt : 1u;
}
__device__ __forceinline__ void xcd_barrier(const XcdBarrier& b, const int wave_s) {
    asm volatile("s_waitcnt vmcnt(0)" ::: "memory");
    __syncthreads();
    int bl_; asm volatile("v_mbcnt_lo_u32_b32 %0, -1, 0\n\tv_mbcnt_hi_u32_b32 %0, -1, %0" : "=v"(bl_));
    if (wave_s == 0 && bl_ == 0) {
        unsigned* bar = b.bar;
        __builtin_amdgcn_s_waitcnt(0);
        unsigned nloc = b.st[0], nx = b.st[1];
        if (nloc == 0u) { xcd_barrier_complete(bar, b.x, nloc, nx); b.st[0] = nloc; b.st[1] = nx; }
        const unsigned gen = b.st[2]; b.st[2] = gen + 1u;
        const bool leader = b.st[3] != 0u;
        (void)__hip_atomic_fetch_add(&bar[XB_XSUB(b.x)], 1u, __ATOMIC_RELAXED, __HIP_MEMORY_SCOPE_AGENT);
        if (leader) {
            const unsigned want = (gen + 1u) * nloc;
            XB_SPIN(xb_ld(&bar[XB_XSUB(b.x)]) < want, bar);
            __builtin_amdgcn_fence(__ATOMIC_RELEASE, "agent");
            asm volatile("s_waitcnt vmcnt(0)" ::: "memory");
            (void)__hip_atomic_fetch_add(&bar[XB_TOP], 1u, __ATOMIC_RELAXED, __HIP_MEMORY_SCOPE_AGENT);
        }
        { const unsigned wantt = (gen + 1u) * nx;
          XB_SPIN(xb_ld(&bar[XB_TOP]) < wantt, bar); }
        __builtin_amdgcn_fence(__ATOMIC_ACQUIRE, "agent");
        asm volatile("s_waitcnt vmcnt(0)" ::: "memory");
    }
    __syncthreads();
}
constexpr int MISC_OFF = LDS_BYTES - 256;
constexpr int CW_BAR = 4096;

struct Args { const float* in[24]; float* out; unsigned char* ws; int ph_lo, ph_hi; };

__device__ __forceinline__ void p0_transpose_item(const float* W, int K, int N, bf16_t* WT, const float* kscale, LAS float* scr, int item, int lane, bool map_in = false, float cscale = 1.0f, const float* nscale = nullptr) {
    const int nblk = N / 32, kb = item / nblk, nb = item % nblk, k0 = 64 * kb, n0 = 32 * nb;
    int d0 = n0;
    if (map_in) {
        if (n0 < C_GL) d0 = P_XL + n0;
        else if (n0 < C_XP) { const int c = n0 - C_GL; d0 = P_FL + (c >> 7) * 256 + (c & 127); }
        else if (n0 < C_GP) d0 = P_XP + (n0 - C_XP);
        else if (n0 < C_ML) { const int c = n0 - C_GP; d0 = P_FL + 2048 + (c >> 7) * 256 + (c & 127); }
        else if (n0 < C_MP) { const int c = n0 - C_ML; d0 = P_FL + (c >> 7) * 256 + 128 + (c & 127); cscale = -1.44269504088896341f; }
        else { const int c = n0 - C_MP; d0 = P_FL + 2048 + (c >> 7) * 256 + 128 + (c & 127); cscale = -1.44269504088896341f; }
    }
    const float ns = (nscale ? nscale[n0 + (lane & 31)] : 1.0f) * cscale;
#pragma unroll 8
    for (int i = 0; i < 32; ++i) { const int kk = 2 * i + (lane >> 5); const float sc = (kscale ? kscale[k0 + kk] : 1.0f) * ns; scr[kk * 33 + (lane & 31)] = W[(size_t)(k0 + kk) * N + n0 + (lane & 31)] * sc; }
    LDS_WAIT(); asm volatile("" ::: "memory");
    const int c = lane & 7;
#pragma unroll
    for (int j = 0; j < 4; ++j) { const int n = (lane >> 3) + 8 * j; const LAS float* s = scr + (8 * c) * 33 + n;
        u32x4 o; o.x = pk2(s[0 * 33], s[1 * 33]); o.y = pk2(s[2 * 33], s[3 * 33]); o.z = pk2(s[4 * 33], s[5 * 33]); o.w = pk2(s[6 * 33], s[7 * 33]);
        *(u32x4*)(WT + (size_t)(d0 + n) * K + k0 + 8 * c) = o; }
    LDS_WAIT(); asm volatile("" ::: "memory");
}

__global__ void __launch_bounds__(NWAVES * 64, 2) fwd(Args args) {
    extern __shared__ __attribute__((aligned(16))) unsigned char lds_raw[];
    LAS unsigned char* lds = (LAS unsigned char*)lds_raw;
    const int G = gridDim.x, bid = blockIdx.x;
    const int NGW = G * NWAVES;
    unsigned char* ws = args.ws;
    const float* x_prompt = args.in[0]; const float* x_sample = args.in[1]; const float* p_prompt = args.in[2]; const float* p_sample = args.in[3];
    const float* state_conv = args.in[4]; const float* state_lru = args.in[5]; const float* state_pool = args.in[6];
    const float* norm_mix = args.in[7]; const float* w_in = args.in[8]; const float* conv_w = args.in[9]; const float* conv_b = args.in[10];
    const float* w_rg_a = args.in[11]; const float* b_rg_a = args.in[12]; const float* w_rg_i = args.in[13]; const float* b_rg_i = args.in[14];
    const float* lru_lambda = args.in[15]; const float* w_pool = args.in[16]; const float* b_pool = args.in[17]; const float* pool_scale = args.in[18];
    const float* w_out = args.in[19]; const float* norm_ple = args.in[20]; const float* w_ple_gate = args.in[21]; const float* w_ple = args.in[22]; const float* final_norm = args.in[23];
    float* out = args.out;
    bf16_t* Wt_in = (bf16_t*)(ws + WS_WIN); bf16_t* Wt_out = (bf16_t*)(ws + WS_WOUT); bf16_t* Wt_pg = (bf16_t*)(ws + WS_WPG); bf16_t* Wt_pe = (bf16_t*)(ws + WS_WPE);
    bf16_t* PB = (bf16_t*)(ws + WS_PB); bf16_t* U = (bf16_t*)(ws + WS_U); bf16_t* MERGED = (bf16_t*)(ws + WS_MERGED);
    float* SS2 = (float*)(ws + WS_SS2); float* RS = (float*)(ws + WS_RS);
    bf16_t* PROJ = (bf16_t*)(ws + WS_PROJ); bf16_t* X2B = (bf16_t*)(ws + WS_X2B); bf16_t* PE = (bf16_t*)(ws + WS_PE); bf16_t* GPRE = (bf16_t*)(ws + WS_GPRE);
    const int lo = args.ph_lo, hi = args.ph_hi;
    const int wave_s = __builtin_amdgcn_readfirstlane(threadIdx.x >> 6);
    if (threadIdx.x < 64) ((LAS unsigned*)(lds + MISC_OFF))[threadIdx.x] = 0u;
    __syncthreads();
    const XcdBarrier xbar = xcd_barrier_post((unsigned*)(ws + WS_CTL) + CW_BAR, (volatile LAS unsigned*)(lds + MISC_OFF) + 8);
#define IN(k) (lo <= (k) && (k) < hi)
#define BOTH(k) (IN(k) && IN((k) + 1))
#define GRID_BAR() do { xcd_barrier(xbar, wave_s); } while (0)

    if (IN(0)) {
      const int tid = opaque_tid(wave_s), lane = tid & 63, wave = wave_s, gw = bid * NWAVES + wave;
      for (int rep = 0; rep < REP_P0; ++rep) {
        LAS float* scr = (LAS float*)(lds + wave * 16384);
        constexpr int I_IN = (D / 64) * (INC / 32), I_SQ = (D / 64) * (D / 32), I_PE = (DPLE / 64) * (D / 32);
        constexpr int I_RG = 16 * 2, I_PL = 4 * 16;
        constexpr int NITEMS = I_IN + 2 * I_SQ + I_PE + 2 * I_RG + I_PL;
        for (int it = gw; it < NITEMS; it += NGW) {
            int r = it;
            if (r >= I_IN + 2 * I_SQ + I_PE) { r -= I_IN + 2 * I_SQ + I_PE;
                if (r < I_RG) { p0_transpose_item(w_rg_a + (r >> 1) * 4096, 64, 64, (bf16_t*)(ws + WS_WRA) + (r >> 1) * 4096, nullptr, scr, r & 1, lane, false, -1.44269504088896341f); continue; } r -= I_RG;
                if (r < I_RG) { p0_transpose_item(w_rg_i + (r >> 1) * 4096, 64, 64, (bf16_t*)(ws + WS_WRI) + (r >> 1) * 4096, nullptr, scr, r & 1, lane, false, -1.44269504088896341f); continue; } r -= I_RG;
                p0_transpose_item(w_pool + (r >> 4) * 32768, 128, 256, (bf16_t*)(ws + WS_WPOOL) + (r >> 4) * 32768, nullptr, scr, r & 15, lane, false, 1.0f, pool_scale + (r >> 4) * 256); continue; }
            if (r < I_IN) { p0_transpose_item(w_in, D, INC, Wt_in, norm_mix, scr, r, lane, true); continue; } r -= I_IN;
            if (r < I_SQ) { p0_transpose_item(w_out, D, D, Wt_out, nullptr, scr, r, lane); continue; } r -= I_SQ;
            if (r < I_SQ) { p0_transpose_item(w_ple_gate, D, D, Wt_pg, norm_ple, scr, r, lane); continue; } r -= I_SQ;
            p0_transpose_item(w_ple, DPLE, D, Wt_pe, nullptr, scr, r, lane);
        }
        if (gw < 16) { const int d = gw * 64 + lane; const float nl = -lru_lambda[d]; ((float*)(ws + WS_C7))[d] = -8.0f * 1.44269504088896341f * (fmaxf(nl, 0.f) + log1pf(expf(-fabsf(nl)))); }
        for (int m = gw; m < M; m += NGW) {
            const float* xrow = (m < NP) ? x_prompt + (size_t)m * D : x_sample + (size_t)(m - NP) * D;
            const f32x4* xr = (const f32x4*)xrow + lane;
            f32x4 v[4]; float s = 0.f;
#pragma unroll
            for (int j = 0; j < 4; ++j) { v[j] = __builtin_nontemporal_load(xr + 64 * j); s += (v[j][0] * v[j][0] + v[j][1] * v[j][1]) + (v[j][2] * v[j][2] + v[j][3] * v[j][3]); }
            const float ms = wave_sum(s) * (1.0f / D) + EPS; const float rstd = __builtin_amdgcn_rsqf(ms);
            if (lane == 0) RS[m] = ms * rstd;
            u32x2* o8 = (u32x2*)(U + (size_t)m * D) + lane;
#pragma unroll
            for (int j = 0; j < 4; ++j) { u32x2 w; w.x = pk2(v[j][0] * rstd, v[j][1] * rstd); w.y = pk2(v[j][2] * rstd, v[j][3] * rstd); o8[64 * j] = w; }
        }
        {
            const size_t nvec = (size_t)M * DPLE / 8, npv = (size_t)NP * DPLE / 8;
            for (size_t i = (size_t)bid * (NWAVES * 64) + tid; i < nvec; i += (size_t)G * NWAVES * 64) {
                const f32x4* src = (i < npv) ? (const f32x4*)p_prompt + 2 * i : (const f32x4*)p_sample + 2 * (i - npv);
                const f32x4 a = __builtin_nontemporal_load(src), b = __builtin_nontemporal_load(src + 1);
                u32x4 w; w.x = pk2(a[0], a[1]); w.y = pk2(a[2], a[3]); w.z = pk2(b[0], b[1]); w.w = pk2(b[2], b[3]);
                ((u32x4*)PB)[i] = w;
            }
        }
      }
        if (BOTH(0)) GRID_BAR();
    }

    if (IN(1)) {
        pg8::Gemm g{U, Wt_in, M, INC, D}; pg8::StaticOrder S; S.init(M, INC, G, bid);
        pg8::EpiProj E{PROJ};
        for (int rep = 0; rep < REP_P1; ++rep) pg8::gemm_phase<pg8::EpiProj, pg8::StaticOrder, true, true>(lds, g, S, E, wave_s);
        if (BOTH(1)) GRID_BAR();
    }

    if (IN(2)) {
        mx::MixP P{PROJ, MERGED, out, state_conv, state_lru, state_pool, conv_w, conv_b, b_rg_a, b_rg_i, (const float*)(ws + WS_C7), b_pool, pool_scale,
                   (const bf16_t*)(ws + WS_WRA), (const bf16_t*)(ws + WS_WRI), (const bf16_t*)(ws + WS_WPOOL)};
#ifndef SAMPLE_REP
#define SAMPLE_REP 1
#endif
        for (int ii = 0; ii < 1 + 2 * SAMPLE_REP; ++ii) mx::mixer_item(lds, P, ii == 0 ? bid : 256 + 2 * bid + ((ii - 1) & 1), wave_s);
        if (BOTH(2)) GRID_BAR();
    }

    if (IN(3)) {
        { pg8::Gemm g{MERGED, Wt_out, M, D, D}; pg8::PanelTail S{bid};
          pg8::EpiRes1 E{U, RS, X2B, SS2};
          pg8::gemm_phase<pg8::EpiRes1, pg8::PanelTail, true, true, true>(lds, g, S, E, wave_s); }
        { pg8::Gemm g{PB, Wt_pe, M, D, DPLE}; pg8::PeA S{bid};
          pg8::EpiBf16 E{PE, D};
          pg8::gemm_phase<pg8::EpiBf16, pg8::PeA, true, true, true>(lds, g, S, E, wave_s); }
        if (BOTH(3)) GRID_BAR();
    }

    if (IN(4)) {
        pg8::Gemm g{X2B, Wt_pg, M, D, D}; pg8::PanelTail S{bid};
        pg8::EpiBf16 E{GPRE, D};
        pg8::gemm_phase<pg8::EpiBf16, pg8::PanelTail, true, true, true>(lds, g, S, E, wave_s);
        { pg8::Gemm g2{PB, Wt_pe, M, D, DPLE}; pg8::PeB S2{bid};
          pg8::EpiBf16 E2{PE, D};
          pg8::gemm_phase<pg8::EpiBf16, pg8::PeB, true, true, true>(lds, g2, S2, E2, wave_s); }
        if (BOTH(4)) GRID_BAR();
    }

    if (IN(5)) {
        const int tid = opaque_tid(wave_s), lane = tid & 63, wave = wave_s, gw = bid * NWAVES + wave;
        f32x4 gsc[4];
#pragma unroll
        for (int j = 0; j < 2; ++j) { gsc[2 * j] = *(const f32x4*)(final_norm + 512 * j + 8 * lane); gsc[2 * j + 1] = *(const f32x4*)(final_norm + 512 * j + 8 * lane + 4); }
        u32x4 xq[2], gq[2], pq[2]; float pv;
#define P5_LOAD(m_) do { const size_t ro = (size_t)(m_) * D + 8 * lane; \
            xq[0] = __builtin_nontemporal_load((const u32x4*)(X2B + ro)); xq[1] = __builtin_nontemporal_load((const u32x4*)(X2B + ro + 512)); gq[0] = __builtin_nontemporal_load((const u32x4*)(GPRE + ro)); gq[1] = __builtin_nontemporal_load((const u32x4*)(GPRE + ro + 512)); \
            pq[0] = __builtin_nontemporal_load((const u32x4*)(PE + ro)); pq[1] = __builtin_nontemporal_load((const u32x4*)(PE + ro + 512)); pv = SS2[(size_t)(m_) * 16 + (lane & 15)]; } while (0)
        int m = gw;
        if (m < M) P5_LOAD(m);
        while (m < M) {
            u32x4 cx[2], cg[2], cp[2]; cx[0] = xq[0]; cx[1] = xq[1]; cg[0] = gq[0]; cg[1] = gq[1]; cp[0] = pq[0]; cp[1] = pq[1]; const float cpv = pv;
            const int mn = m + NGW;
            if (mn < M) P5_LOAD(mn);
            float t16 = cpv; t16 += dpp_mov<0xB1>(t16); t16 += dpp_mov<0x4E>(t16); t16 += dpp_mov<0x141>(t16); t16 += dpp_mov<0x140>(t16);
            const float rstd2 = __builtin_amdgcn_rsqf(t16 * (1.0f / D) + EPS);
            float v[16]; float s = 0.f;
#pragma unroll
            for (int j = 0; j < 2; ++j)
#pragma unroll
                for (int q = 0; q < 4; ++q) {
                    const unsigned xw = cx[j][q], gw2 = cg[j][q], pw = cp[j][q];
                    const float x0 = __uint_as_float(xw << 16), x1 = __uint_as_float(xw & 0xffff0000u);
                    const float g0 = __uint_as_float(gw2 << 16) * rstd2, g1 = __uint_as_float(gw2 & 0xffff0000u) * rstd2;
                    const float p0 = __uint_as_float(pw << 16), p1 = __uint_as_float(pw & 0xffff0000u);
                    const float y0 = x0 + p0 * sigm(g0), y1 = x1 + p1 * sigm(g1);
                    v[8 * j + 2 * q] = y0; v[8 * j + 2 * q + 1] = y1; s += y0 * y0 + y1 * y1;
                }
            const float rstd3 = __builtin_amdgcn_rsqf(wave_sum(s) * (1.0f / D) + EPS);
            float* yr = out + O_Y + (size_t)m * D + 8 * lane;
#pragma unroll
            for (int j = 0; j < 2; ++j) {
                f32x4 o0, o1;
#pragma unroll
                for (int q = 0; q < 4; ++q) { o0[q] = v[8 * j + q] * rstd3 * gsc[2 * j][q]; o1[q] = v[8 * j + 4 + q] * rstd3 * gsc[2 * j + 1][q]; }
                __builtin_nontemporal_store(o0, (f32x4*)(yr + 512 * j)); __builtin_nontemporal_store(o1, (f32x4*)(yr + 512 * j + 4));
            }
            m = mn;
        }
#undef P5_LOAD
    }
#undef IN
#undef BOTH
#undef GRID_BAR
}

extern "C" void kernel_launch(void* const* d_in, const int* in_sizes, int n_in, void* d_out, int out_size, void* d_ws, size_t ws_size, hipStream_t stream) {
    static int grid = 0;
    if (grid == 0) {
        if (n_in != 24 || (size_t)out_size != O_END || ws_size < WS_END) { fprintf(stderr, "kernel_launch: unexpected shapes: n_in %d out %d ws %zu\n", n_in, out_size, ws_size); grid = -1; return; }
        if (hipFuncSetAttribute((const void*)fwd, hipFuncAttributeMaxDynamicSharedMemorySize, LDS_BYTES) != hipSuccess) { fprintf(stderr, "kernel_launch: hipFuncSetAttribute failed\n"); grid = -1; return; }
        int dev = 0, cus = 0, per_cu = 0;
        (void)hipGetDevice(&dev); (void)hipDeviceGetAttribute(&cus, hipDeviceAttributeMultiprocessorCount, dev);
        (void)hipOccupancyMaxActiveBlocksPerMultiprocessor(&per_cu, (const void*)fwd, NWAVES * 64, LDS_BYTES);
        (void)hipGetLastError();
        if (cus != 256 || per_cu < 1) { fprintf(stderr, "kernel_launch: built for 256 CUs x 1 block; got %d CUs, %d blocks/CU\n", cus, per_cu); grid = -1; return; }
        grid = 256;
    }
    if (grid < 0) return;
    Args a{};
    for (int i = 0; i < 24; ++i) a.in[i] = (const float*)d_in[i];
    a.out = (float*)d_out; a.ws = (unsigned char*)d_ws;
#ifndef PHASE_SEQ
#define PHASE_SEQ {{0, 6}}
#endif
    static const int seq[][2] = PHASE_SEQ;
    hipError_t e = hipSuccess;
    for (unsigned li = 0; li < sizeof(seq) / sizeof(seq[0]); ++li) {
        if (hipMemsetAsync((char*)d_ws + WS_CTL, 0, CTL_ZERO_BYTES, stream) != hipSuccess) { fprintf(stderr, "kernel_launch: hipMemsetAsync failed\n"); return; }
        a.ph_lo = seq[li][0]; a.ph_hi = seq[li][1];
        hipLaunchKernelGGL(fwd, dim3(grid), dim3(NWAVES * 64), LDS_BYTES, stream, a);
        e = hipPeekAtLastError(); if (e != hipSuccess) break;
    }
    if (e != hipSuccess) fprintf(stderr, "kernel_launch: launch failed: %s\n", hipGetErrorString(e));
}
```
